# Optimizing an MI355X kernel written in HIP

```python
import jax
import jax.numpy as jnp
from jax import lax
import numpy as np

D_MODEL = 2048
BATCH = 4
SEQ = 4096
DEPTH = 2

GRID_W = 64
CTX_LEN = 256
N_MOD = 9
D_FF = 5632
RMS_EPS = 1e-6
ROPE_BASE = 10000.0

GLA_HEADS = 4
GLA_DK = D_MODEL // 16
GLA_DV = D_MODEL // 8
GLA_LOWRANK = 16
GLA_TAU = 16.0
GLA_CHUNK = 64
FNET_GROUPS = 4
FNET_GROUP_DIM = D_MODEL // 8
GLA_QK_W = GLA_HEADS * GLA_DK
GLA_V_W = GLA_HEADS * GLA_DV
FNET_W = FNET_GROUPS * FNET_GROUP_DIM
AB_SPLITS = (GLA_QK_W, 2 * GLA_QK_W, 2 * GLA_QK_W + GLA_V_W,
             2 * GLA_QK_W + GLA_V_W + GLA_LOWRANK, 2 * GLA_QK_W + GLA_V_W + 2 * GLA_LOWRANK,
             2 * GLA_QK_W + 2 * GLA_V_W + 2 * GLA_LOWRANK)
AB_IN_W = AB_SPLITS[-1] + FNET_W
AB_MIX_W = GLA_V_W + FNET_W

NA_HEADS = D_MODEL // 64
NA_HEAD_DIM = D_MODEL // NA_HEADS
NA_KH_MAX = 8
NA_KW = 16

kernel_name = 'hybrid_gla_fnet_natten_macaron_dit'

F32 = jnp.float32


def rms_norm(x, g):
    x32 = x.astype(F32)
    y = x32 * lax.rsqrt(jnp.mean(x32 * x32, axis=-1, keepdims=True) + RMS_EPS)
    return (y * g.astype(F32)).astype(x.dtype)


def modulate(h, shift, scale):
    return h * (1 + scale) + shift


def swiglu(h, w_gu, w_down):
    a, u = jnp.split(h @ w_gu, 2, axis=-1)
    return (jax.nn.silu(a) * u) @ w_down


def split_heads(z, n_heads):
    b, t, hd = z.shape
    return z.reshape(b, t, n_heads, hd // n_heads).transpose(0, 2, 1, 3)


def merge_heads(z):
    b, h, t, d = z.shape
    return z.transpose(0, 2, 1, 3).reshape(b, t, h * d)


def _rope_axis(x, pos):
    half = x.shape[-1] // 2
    inv_freq = ROPE_BASE ** (-jnp.arange(half, dtype=F32) / half)
    ang = pos.astype(F32)[:, None] * inv_freq[None, :]
    cos, sin = jnp.cos(ang), jnp.sin(ang)
    x1 = x[..., :half].astype(F32)
    x2 = x[..., half:].astype(F32)
    return jnp.concatenate([x1 * cos - x2 * sin, x1 * sin + x2 * cos], axis=-1).astype(x.dtype)


def axial_rope_2d(x):
    t = jnp.arange(x.shape[-2])
    row, col = t // GRID_W, t % GRID_W
    h = x.shape[-1] // 2
    return jnp.concatenate([_rope_axis(x[..., :h], row), _rope_axis(x[..., h:], col)], axis=-1)


def gla_chunked(q, k, v, g, s0):
    b, h, t, dk = q.shape
    dv = v.shape[-1]
    n = t // GLA_CHUNK

    def to_chunks(a):
        return a.reshape(b, h, n, GLA_CHUNK, a.shape[-1]).transpose(2, 0, 1, 3, 4).astype(F32)

    causal = jnp.tril(jnp.ones((GLA_CHUNK, GLA_CHUNK), dtype=bool))

    def step(s, inp):
        qi, ki, vi, gi = inp
        bc = jnp.cumsum(gi, axis=2)
        o_inter = jnp.einsum('bhtk,bhkv->bhtv', qi * jnp.exp(bc), s)
        diff = bc[:, :, :, None, :] - bc[:, :, None, :, :]
        decay = jnp.exp(jnp.where(causal[:, :, None], diff, -jnp.inf))
        att = jnp.einsum('bhtk,bhsk,bhtsk->bhts', qi, ki, decay)
        o = o_inter + jnp.einsum('bhts,bhsv->bhtv', att, vi)
        b_last = bc[:, :, -1:, :]
        s_new = (jnp.exp(b_last[:, :, 0, :])[..., None] * s
                 + jnp.einsum('bhsk,bhsv->bhkv', ki * jnp.exp(b_last - bc), vi))
        return s_new, o

    s_fin, oc = lax.scan(step, s0.astype(F32), (to_chunks(q), to_chunks(k), to_chunks(v), to_chunks(g)))
    return oc.transpose(1, 2, 0, 3, 4).reshape(b, h, t, dv), s_fin


def gla_bidirectional(q, k, v, g_f, g_b, s_f0, s_b0):
    rev = lambda a: jnp.flip(a, axis=2)
    o_f, s_f = gla_chunked(q, k, v, g_f, s_f0)
    o_b, s_b = gla_chunked(rev(q), rev(k), rev(v), rev(g_b), s_b0)
    return o_f + rev(o_b), s_f, s_b


def _gla_fnet_project(u, w_in, gw_f, gb_f, gw_b, gb_b, rotary):
    q, k, v, lr_f, lr_b, r, f = jnp.split(u @ w_in, AB_SPLITS, axis=-1)
    q = split_heads(q, GLA_HEADS) * (GLA_DK ** -0.5)
    k = split_heads(k, GLA_HEADS)
    if rotary:
        q, k = axial_rope_2d(q), axial_rope_2d(k)
    v = split_heads(v, GLA_HEADS)
    g_f = split_heads(jax.nn.log_sigmoid((lr_f @ gw_f + gb_f).astype(F32)) / GLA_TAU, GLA_HEADS)
    g_b = split_heads(jax.nn.log_sigmoid((lr_b @ gw_b + gb_b).astype(F32)) / GLA_TAU, GLA_HEADS)
    b, t, _ = f.shape
    fg = f.reshape(b, t, FNET_GROUPS, FNET_GROUP_DIM).astype(F32)
    f_mix = jnp.fft.fft2(fg, axes=(1, 3), norm='ortho').real.reshape(b, t, FNET_W).astype(u.dtype)
    return q, k, v, g_f, g_b, r, f_mix


def _gla_fnet_out(o, r, f_mix, g_norm, w_out):
    o = o * lax.rsqrt(jnp.mean(o * o, axis=-1, keepdims=True) + RMS_EPS)
    o = merge_heads(o) * g_norm.astype(F32) * jax.nn.silu(r.astype(F32))
    return jnp.concatenate([o.astype(f_mix.dtype), f_mix], axis=-1) @ w_out


def mix_gla_fnet(u, uc, need_ctx, w_in, gw_f, gb_f, gw_b, gb_b, g_norm, w_out):
    qc, kc, vc, gfc, gbc, rc, fc = _gla_fnet_project(uc, w_in, gw_f, gb_f, gw_b, gb_b, rotary=False)
    zeros = jnp.zeros((uc.shape[0], GLA_HEADS, GLA_DK, GLA_DV), F32)
    oc, s_f, s_b = gla_bidirectional(qc, kc, vc, gfc, gbc, zeros, zeros)
    q, k, v, gf, gb, r, f = _gla_fnet_project(u, w_in, gw_f, gb_f, gw_b, gb_b, rotary=True)
    o, _, _ = gla_bidirectional(q, k, v, gf, gb, s_f, s_b)
    y = _gla_fnet_out(o, r, f, g_norm, w_out)
    yc = _gla_fnet_out(oc, rc, fc, g_norm, w_out) if need_ctx else None
    return y, yc


def mix_neighbourhood(u, uc, need_ctx, w_qkv, rpb, w_out):
    b, t, _ = u.shape
    rows = t // GRID_W
    kh = min(NA_KH_MAX, rows)
    scale = NA_HEAD_DIM ** -0.5
    q, k, v = (split_heads(z, NA_HEADS) for z in jnp.split(u @ w_qkv, 3, axis=-1))
    q = q * scale
    kc, vc = (split_heads(z, NA_HEADS) for z in jnp.split(uc @ w_qkv[:, D_MODEL:], 2, axis=-1))
    grid = lambda z: z.reshape(b, NA_HEADS, rows, GRID_W, NA_HEAD_DIM)
    qg, kg, vg = grid(q), grid(k), grid(v)
    col = jnp.arange(GRID_W)
    col_start = jnp.clip(col - NA_KW // 2, 0, GRID_W - NA_KW)
    col_mask = (col[None, :] >= col_start[:, None]) & (col[None, :] < col_start[:, None] + NA_KW)
    dc_idx = jnp.clip(col[None, :] - col[:, None] + NA_KW - 1, 0, 2 * NA_KW - 2)
    rpb32 = rpb.astype(F32)
    n_loc = kh * GRID_W

    def row_block(r):
        r0 = jnp.clip(r - kh // 2, 0, rows - kh)
        kb = lax.dynamic_slice_in_dim(kg, r0, kh, axis=2)
        vb = lax.dynamic_slice_in_dim(vg, r0, kh, axis=2)
        qr = lax.dynamic_index_in_dim(qg, r, axis=2, keepdims=False)
        dr_idx = r0 + jnp.arange(kh) - r + NA_KH_MAX - 1
        bias = rpb32[:, dr_idx[:, None, None], dc_idx[None, :, :]].transpose(0, 2, 1, 3)
        s_loc = jnp.einsum('bhqd,bhikd->bhqik', qr, kb).astype(F32) + bias
        s_loc = jnp.where(col_mask[:, None, :], s_loc, -jnp.inf).reshape(b, NA_HEADS, GRID_W, n_loc)
        s_ctx = jnp.einsum('bhqd,bhcd->bhqc', qr, kc).astype(F32)
        p = jax.nn.softmax(jnp.concatenate([s_loc, s_ctx], axis=-1), axis=-1).astype(v.dtype)
        p_loc = p[..., :n_loc].reshape(b, NA_HEADS, GRID_W, kh, GRID_W)
        return (jnp.einsum('bhqik,bhikd->bhqd', p_loc, vb)
                + jnp.einsum('bhqc,bhcd->bhqd', p[..., n_loc:], vc))

    o = lax.map(row_block, jnp.arange(rows))
    o = o.transpose(1, 2, 0, 3, 4).reshape(b, NA_HEADS, t, NA_HEAD_DIM)
    y = merge_heads(o) @ w_out
    yc = None
    if need_ctx:
        qc = split_heads(uc @ w_qkv[:, :D_MODEL], NA_HEADS) * scale
        pc = jax.nn.softmax(jnp.einsum('bhqd,bhcd->bhqc', qc, kc).astype(F32), axis=-1).astype(vc.dtype)
        yc = merge_heads(jnp.einsum('bhqc,bhcd->bhqd', pc, vc)) @ w_out
    return y, yc


def trunk_layer(x, xc, c, c_ctx, common, mixer, last):
    ada_w, ada_b, n_ffn1, n_mix, n_ffn2, f1_gu, f1_down, f2_gu, f2_down = common
    m = jnp.split((jax.nn.silu(c) @ ada_w + ada_b)[:, None, :], N_MOD, axis=-1)
    mc = jnp.split((jax.nn.silu(c_ctx) @ ada_w + ada_b)[None, None, :], N_MOD, axis=-1)
    sub_in = lambda h, g, mm, j: modulate(rms_norm(h, g), mm[3 * j], mm[3 * j + 1])
    x = x + 0.5 * m[2] * swiglu(sub_in(x, n_ffn1, m, 0), f1_gu, f1_down)
    xc = xc + 0.5 * mc[2] * swiglu(sub_in(xc, n_ffn1, mc, 0), f1_gu, f1_down)
    y, yc = mixer(sub_in(x, n_mix, m, 1), sub_in(xc, n_mix, mc, 1), not last)
    x = x + m[5] * y
    x = x + 0.5 * m[8] * swiglu(sub_in(x, n_ffn2, m, 2), f2_gu, f2_down)
    if not last:
        xc = xc + mc[5] * yc
        xc = xc + 0.5 * mc[8] * swiglu(sub_in(xc, n_ffn2, mc, 2), f2_gu, f2_down)
    return x, xc


def setup_inputs(seed: int = 0) -> dict:
    key = jax.random.key(seed)
    keys = iter(jax.random.split(key, 48))
    D = D_MODEL

    def normal(shape, scale):
        return jax.random.normal(next(keys), shape, F32) * scale

    def gain(n):
        return 1.0 + 0.02 * jax.random.normal(next(keys), (n,), F32)

    def common(p):
        return {p + 'ada_w': normal((D, N_MOD * D), 0.5 * D ** -0.5),
                p + 'ada_b': normal((N_MOD * D,), 0.02),
                p + 'norm_ffn1': gain(D), p + 'norm_mix': gain(D), p + 'norm_ffn2': gain(D),
                p + 'ffn1_w_gu': normal((D, 2 * D_FF), D ** -0.5),
                p + 'ffn1_w_down': normal((D_FF, D), D_FF ** -0.5),
                p + 'ffn2_w_gu': normal((D, 2 * D_FF), D ** -0.5),
                p + 'ffn2_w_down': normal((D_FF, D), D_FF ** -0.5)}

    inputs = {'x': normal((BATCH, SEQ, D), 1.0),
              'c': normal((BATCH, D), 1.0),
              'ctx': normal((BATCH, CTX_LEN, D), 1.0),
              'c_ctx': normal((D,), 1.0)}
    inputs.update(common('l0_'))
    inputs.update({'l0_w_in': normal((D, AB_IN_W), D ** -0.5),
                   'l0_gla_gate_w_fwd': normal((GLA_LOWRANK, GLA_QK_W), GLA_LOWRANK ** -0.5),
                   'l0_gla_gate_b_fwd': normal((GLA_QK_W,), 0.02),
                   'l0_gla_gate_w_bwd': normal((GLA_LOWRANK, GLA_QK_W), GLA_LOWRANK ** -0.5),
                   'l0_gla_gate_b_bwd': normal((GLA_QK_W,), 0.02),
                   'l0_gla_norm': gain(GLA_V_W),
                   'l0_w_out': normal((AB_MIX_W, D), AB_MIX_W ** -0.5)})
    inputs.update(common('l1_'))
    inputs.update({'l1_w_qkv': normal((D, 3 * D), D ** -0.5),
                   'l1_rpb': normal((NA_HEADS, 2 * NA_KH_MAX - 1, 2 * NA_KW - 1), 0.1),
                   'l1_w_out': normal((D, D), D ** -0.5)})
    inputs['norm_out'] = gain(D)
    return inputs


def reference(x, c, ctx, c_ctx,
              l0_ada_w, l0_ada_b, l0_norm_ffn1, l0_norm_mix, l0_norm_ffn2,
              l0_ffn1_w_gu, l0_ffn1_w_down, l0_ffn2_w_gu, l0_ffn2_w_down,
              l0_w_in, l0_gla_gate_w_fwd, l0_gla_gate_b_fwd, l0_gla_gate_w_bwd, l0_gla_gate_b_bwd,
              l0_gla_norm, l0_w_out,
              l1_ada_w, l1_ada_b, l1_norm_ffn1, l1_norm_mix, l1_norm_ffn2,
              l1_ffn1_w_gu, l1_ffn1_w_down, l1_ffn2_w_gu, l1_ffn2_w_down,
              l1_w_qkv, l1_rpb, l1_w_out,
              norm_out):
    layers = [
        ((l0_ada_w, l0_ada_b, l0_norm_ffn1, l0_norm_mix, l0_norm_ffn2,
          l0_ffn1_w_gu, l0_ffn1_w_down, l0_ffn2_w_gu, l0_ffn2_w_down),
         lambda u, uc, need: mix_gla_fnet(u, uc, need, l0_w_in, l0_gla_gate_w_fwd, l0_gla_gate_b_fwd,
                                          l0_gla_gate_w_bwd, l0_gla_gate_b_bwd, l0_gla_norm, l0_w_out)),
        ((l1_ada_w, l1_ada_b, l1_norm_ffn1, l1_norm_mix, l1_norm_ffn2,
          l1_ffn1_w_gu, l1_ffn1_w_down, l1_ffn2_w_gu, l1_ffn2_w_down),
         lambda u, uc, need: mix_neighbourhood(u, uc, need, l1_w_qkv, l1_rpb, l1_w_out)),
    ]
    xc = ctx
    for i in range(DEPTH):
        common, mixer = layers[i]
        x, xc = trunk_layer(x, xc, c, c_ctx, common, mixer, last=(i == DEPTH - 1))
    return rms_norm(x, norm_out)
```

```cpp
#include <hip/hip_runtime.h>
#include <cstdio>
#include <cstdint>

#ifndef MK_FUSED
#define MK_FUSED 1
#endif

#define GAS __attribute__((address_space(1)))
#define LAS __attribute__((address_space(3)))
typedef unsigned short bf16;
typedef short bf16x8 __attribute__((ext_vector_type(8)));
typedef short bf16x4 __attribute__((ext_vector_type(4)));
typedef float f32x4 __attribute__((ext_vector_type(4)));
typedef float f32x2 __attribute__((ext_vector_type(2)));
typedef unsigned u32x4 __attribute__((ext_vector_type(4)));
typedef unsigned u32x2 __attribute__((ext_vector_type(2)));

constexpr int D = 2048, NB = 4, T = 4096, TC = 256, ML = NB * T, MC = NB * TC, MT = ML + MC, FF = 5632, NMODW = 9 * D;
constexpr int ZW = 4352;
constexpr int QW = 6144;
constexpr float RMS_EPS = 1e-6f;

constexpr size_t MiB = 1u << 20;
constexpr size_t WS_CTL = 0, WS_MODS = 1 * MiB, CTL_ZERO_BYTES = 2 * MiB;
constexpr size_t WS_DFTC = 2 * MiB, WS_DFT256 = 2 * MiB + 256 * 1024, WS_ROPE = 2 * MiB + 512 * 1024;
constexpr size_t WS_WA = 2 * MiB + 768 * 1024, WS_WB = WS_WA + 64 * 1024, WS_TW = 3 * MiB;
constexpr size_t WS_YP = 4 * MiB;
constexpr size_t WS_W = 68 * MiB;
constexpr size_t W_GU1 = WS_W, W_GU2 = WS_W + 44 * MiB, W_D1 = WS_W + 88 * MiB, W_D2 = WS_W + 110 * MiB, W_MIXA = WS_W + 132 * MiB, W_OUT = WS_W + 156 * MiB;
constexpr size_t WS_XR = 232 * MiB;
constexpr size_t WS_U = 368 * MiB;
constexpr size_t WS_MIX = 436 * MiB;
constexpr size_t WS_BIG = 504 * MiB;
constexpr size_t WS_F1T = 708 * MiB;
constexpr size_t WS_F1TC = 772 * MiB;
constexpr size_t WS_DST = 776 * MiB;
constexpr size_t WS_QP = 912 * MiB;
constexpr size_t WS_ATT = 946 * MiB;
constexpr size_t WS_AD = 955 * MiB;
constexpr size_t WS_SLAB = 957 * MiB;
constexpr size_t WS_END = 989 * MiB;
constexpr int CW_BAR = 4096;

__device__ __forceinline__ float bf2f(unsigned short h) { return __builtin_bit_cast(float, (unsigned)h << 16); }
typedef __bf16 bf16x2_t __attribute__((ext_vector_type(2)));
__device__ __forceinline__ unsigned pk2(float lo, float hi) { const f32x2 v = {lo, hi}; return __builtin_bit_cast(unsigned, __builtin_convertvector(v, bf16x2_t)); }
__device__ __forceinline__ unsigned f2bf(float f) { return pk2(f, 0.f) & 0xffffu; }
__device__ __forceinline__ float wave_sum(float v) {
#pragma unroll
    for (int o = 1; o < 64; o <<= 1) v += __shfl_xor(v, o);
    return v;
}
__device__ __forceinline__ float wave_max(float v) {
#pragma unroll
    for (int o = 1; o < 64; o <<= 1) v = fmaxf(v, __shfl_xor(v, o));
    return v;
}
__device__ __forceinline__ float rdl(float v, int l) { return __builtin_bit_cast(float, __builtin_amdgcn_readlane(__builtin_bit_cast(int, v), l)); }
__device__ __forceinline__ int rdli(int v, int l) { return __builtin_amdgcn_readlane(v, l); }
__device__ __forceinline__ float silu_f(float x) { return x / (1.f + __expf(-x)); }

namespace pg8 {
#define PG8_LAS __attribute__((address_space(3)))
constexpr int BM = 256, BK = 64, HALF = 128, HTB = HALF * BK * 2, STAGE_BYTES = 8 * HTB, NXCD = 8, WGM = 4;
__host__ __device__ __forceinline__ int lds_byte(int r, int c) { const int st = (r >> 4) * 2 + (c >> 5), rr = r & 15, cc = c & 31, ob = rr * 64 + cc * 2; return st * 1024 + (ob ^ (((ob >> 9) & 1) << 5)); }
__host__ __device__ __forceinline__ void stage_rc(int b, int& R, int& C) { const int st = b / 1024, sb = b % 1024, swz = sb ^ (((sb >> 9) & 1) << 5); R = (st >> 1) * 16 + swz / 64; C = (st & 1) * 32 + (swz % 64) / 2; }
__host__ __device__ __forceinline__ int perm32(int rho) { const int n = rho >> 4, i = rho & 15; return 8 * (i >> 2) + 4 * n + (i & 3); }

struct Unit { int pm, pn; const char* a; const char* b; long ooff; int ldc; float sc; int nt, flags; };
struct Gemm { int lda, ldb, K, bmap, ksA, ksB; };

struct TileOrder {
    int nM, nN, nwg;
    __device__ __forceinline__ void init(int nM_, int nN_) { nM = nM_; nN = nN_; nwg = nM_ * nN_; }
    __device__ __forceinline__ void decode(int L, int& pm, int& pn) const {
        int wgid = L; { const int q = nwg / NXCD, r = nwg % NXCD, xcd = wgid % NXCD, off = wgid / NXCD; wgid = (xcd < r ? xcd * (q + 1) : r * (q + 1) + (xcd - r) * q) + off; }
        const int nig = WGM * nN, gid = wgid / nig, fm = gid * WGM, gsz = (nM - fm) < WGM ? (nM - fm) : WGM;
        pm = fm + ((wgid % nig) % gsz); pn = (wgid % nig) / gsz;
    }
};
struct PlainSched {
    TileOrder to; int G, c, ntk; const char* A; const char* Bt; size_t a_t, b_t;
    __device__ __forceinline__ void init(const void* A_, int lda, int nM, const void* Bt_, int ldb, int nN, int K, int G_, int c_) { to.init(nM, nN); G = G_; c = c_; ntk = K / BK; A = (const char*)A_; Bt = (const char*)Bt_; a_t = (size_t)BM * lda * 2; b_t = (size_t)BM * ldb * 2; }
    __device__ __forceinline__ bool next(int i, Unit& u) const {
        const long L = (long)i * G + c; if (L >= to.nwg) return false;
        to.decode((int)L, u.pm, u.pn); u.a = A + (size_t)u.pm * a_t; u.b = Bt + (size_t)u.pn * b_t; u.ooff = 0; u.ldc = 0; u.sc = 1.f; u.nt = ntk; u.flags = 0; return true;
    }
};

__device__ __forceinline__ unsigned cvt_pk_bf16(float lo, float hi) { unsigned r; asm volatile("v_cvt_pk_bf16_f32 %0, %1, %2" : "=v"(r) : "v"(lo), "v"(hi)); return r; }

struct EpiStore {
    static constexpr bool PERM = true;
    bf16* O;
    __device__ __forceinline__ void operator()(const f32x4 (&acc)[2][2][4][2], const Unit& u, int wr, int wc, int fr, int fq) const {
        const bool pc = (u.flags & 8) != 0;
        bf16* base = O + u.ooff + (size_t)(wr * 64 + fr) * u.ldc + (pc ? (wc >> 1) * 128 + (wc & 1) * 32 : wc * 32) + 8 * fq; const float sc = u.sc;
#pragma unroll
        for (int ai = 0; ai < 2; ++ai)
#pragma unroll
            for (int m = 0; m < 4; ++m) { bf16* rowp = base + (size_t)(ai * HALF + m * 16) * u.ldc;
#pragma unroll
                for (int bj = 0; bj < 2; ++bj) { const f32x4 v0 = acc[ai][bj][m][0] * sc, v1 = acc[ai][bj][m][1] * sc;
                    u32x4 w; w.x = cvt_pk_bf16(v0[0], v0[1]); w.y = cvt_pk_bf16(v0[2], v0[3]); w.z = cvt_pk_bf16(v1[0], v1[1]); w.w = cvt_pk_bf16(v1[2], v1[3]);
                    *(u32x4*)(rowp + bj * (pc ? 256 : HALF)) = w; } }
    }
};
struct EpiFnA {
    static constexpr bool PERM = true;
    bf16* Y; const float* TW;
    __device__ __forceinline__ void operator()(const f32x4 (&acc)[2][2][4][2], const Unit& u, int wr, int wc, int fr, int fq) const {
        if (wr != 0) return;
#pragma unroll
        for (int bj = 0; bj < 2; ++bj) { const int rho = u.pn * BM + bj * HALF + wc * 32 + 8 * fq, t2 = rho & 63, nb = rho >> 6, b = nb >> 10, n = nb & 1023;
#pragma unroll
            for (int m = 0; m < 4; ++m) { const int t1p = 16 * m + fr; const float* tw = TW + (t1p * 64 + t2) * 2; float yp[8], yq[8];
#pragma unroll
                for (int h = 0; h < 4; ++h) { const f32x4 cs = *(const f32x4*)(tw + 4 * h);
                    const float p0 = acc[0][bj][m][h >> 1][2 * (h & 1)], q0 = acc[1][bj][m][h >> 1][2 * (h & 1)], p1 = acc[0][bj][m][h >> 1][2 * (h & 1) + 1], q1 = acc[1][bj][m][h >> 1][2 * (h & 1) + 1];
                    yp[2 * h] = cs.x * p0 - cs.y * q0; yq[2 * h] = cs.y * p0 + cs.x * q0; yp[2 * h + 1] = cs.z * p1 - cs.w * q1; yq[2 * h + 1] = cs.w * p1 + cs.z * q1; }
                bf16* o = Y + (((size_t)(b * 64 + t1p) * 1024 + n) * 128 + t2);
                u32x4 w; w.x = cvt_pk_bf16(yp[0], yp[1]); w.y = cvt_pk_bf16(yp[2], yp[3]); w.z = cvt_pk_bf16(yp[4], yp[5]); w.w = cvt_pk_bf16(yp[6], yp[7]); *(u32x4*)o = w;
                w.x = cvt_pk_bf16(yq[0], yq[1]); w.y = cvt_pk_bf16(yq[2], yq[3]); w.z = cvt_pk_bf16(yq[4], yq[5]); w.w = cvt_pk_bf16(yq[6], yq[7]); *(u32x4*)(o + 64) = w; } }
    }
};
struct EpiFnB {
    static constexpr bool PERM = true;
    bf16* M;
    __device__ __forceinline__ void operator()(const f32x4 (&acc)[2][2][4][2], const Unit& u, int wr, int wc, int fr, int fq) const {
        if (wr != 0) return;
#pragma unroll
        for (int bj = 0; bj < 2; ++bj) { const int sg = u.pn * BM + bj * HALF + wc * 32 + 8 * fq, n = sg & 1023, t1p = (sg >> 10) & 63, b = sg >> 16;
#pragma unroll
            for (int m = 0; m < 4; ++m) { const int t2p = 16 * m + fr; const f32x4 v0 = acc[0][bj][m][0], v1 = acc[0][bj][m][1];
                u32x4 w; w.x = cvt_pk_bf16(v0[0], v0[1]); w.y = cvt_pk_bf16(v0[2], v0[3]); w.z = cvt_pk_bf16(v1[0], v1[1]); w.w = cvt_pk_bf16(v1[2], v1[3]);
                *(u32x4*)(M + (size_t)(b * T + t1p + 64 * t2p) * D + 1024 + n) = w; } }
    }
};
constexpr size_t NA_KF = (size_t)NB * 32 * 64 * 2 * 4 * 512, NA_VF = NA_KF + (size_t)NB * 32 * 136 * 4 * 512;
struct EpiQkvFrag {
    static constexpr bool PERM = true;
    bf16* O;
    __device__ __forceinline__ void operator()(const f32x4 (&acc)[2][2][4][2], const Unit& u, int wr, int wc, int fr, int fq) const {
        const float sc = u.sc;
#pragma unroll
        for (int ai = 0; ai < 2; ++ai)
#pragma unroll
            for (int m = 0; m < 4; ++m) { const int row = u.pm * BM + ai * HALF + wr * 64 + m * 16 + fr;
#pragma unroll
                for (int bj = 0; bj < 2; ++bj) { const int col = u.pn * BM + bj * HALF + wc * 32 + 8 * fq;
                    const f32x4 v0 = acc[ai][bj][m][0] * sc, v1 = acc[ai][bj][m][1] * sc;
                    u32x4 w; w.x = cvt_pk_bf16(v0[0], v0[1]); w.y = cvt_pk_bf16(v0[2], v0[3]); w.z = cvt_pk_bf16(v1[0], v1[1]); w.w = cvt_pk_bf16(v1[2], v1[3]);
                    const int tr = (u.flags & 2) ? col : row;
                    int b, tile, tau; if (tr < ML) { b = tr >> 12; tile = (tr & 4095) >> 5; tau = tr & 31; } else { const int j = tr - ML; b = j >> 8; tile = 128 + ((j & 255) >> 5); tau = j & 31; }
                    if (u.flags & 2) { const int h = row >> 6, d = row & 63;
                        *(u32x4*)(O + NA_VF + ((((size_t)(b * 32 + h) * 136 + tile) * 2 + (d >> 5)) * 2 + ((tau >> 3) & 1)) * 512 + (((tau >> 4) & 1) * 32 + (d & 31)) * 8) = w; }
                    else { const int cc = col & 2047, h = cc >> 6, c8 = (cc & 63) >> 3;
                        if (col >= 2048) { const int l32 = (((tau >> 3) & 1) << 4) | (((tau >> 2) & 1) << 3) | (((tau >> 4) & 1) << 2) | (tau & 3);
                            *(u32x4*)(O + NA_KF + (((size_t)(b * 32 + h) * 136 + tile) * 4 + (c8 >> 1)) * 512 + ((c8 & 1) * 32 + l32) * 8) = w; }
                        else if (tr < ML) { const int t = tr & 4095;
                            *(u32x4*)(O + ((((size_t)(b * 32 + h) * 64 + (t >> 6)) * 2 + ((t >> 5) & 1)) * 4 + (c8 >> 1)) * 512 + ((c8 & 1) * 32 + (t & 31)) * 8) = w; } } } }
    }
};
struct EpiSwiGLU {
    static constexpr bool PERM = true;
    bf16* H;
    __device__ __forceinline__ void operator()(const f32x4 (&acc)[2][2][4][2], const Unit& u, int wr, int wc, int fr, int fq) const {
        bf16* base = H + (((size_t)u.pm * (FF / 64) + 2 * u.pn + (wc >> 1)) * BM + wr * 64 + fr) * 64 + (wc & 1) * 32 + 8 * fq;
#pragma unroll
        for (int ai = 0; ai < 2; ++ai)
#pragma unroll
            for (int m = 0; m < 4; ++m) { float h[8];
#pragma unroll
                for (int n = 0; n < 2; ++n)
#pragma unroll
                    for (int e = 0; e < 4; ++e) { const float a = acc[ai][0][m][n][e], g = acc[ai][1][m][n][e];
                        h[4 * n + e] = a * __builtin_amdgcn_rcpf(1.f + __builtin_amdgcn_exp2f(-1.4426950408889634f * a)) * g; }
                u32x4 w; w.x = cvt_pk_bf16(h[0], h[1]); w.y = cvt_pk_bf16(h[2], h[3]); w.z = cvt_pk_bf16(h[4], h[5]); w.w = cvt_pk_bf16(h[6], h[7]);
                *(u32x4*)(base + (size_t)(ai * HALF + m * 16) * 64) = w; }
    }
};
struct EpiResid {
    static constexpr bool PERM = false;
    const float* base_lat; const float* base_ctx; float* out; const float* gate; float* slab; float gs;
    __device__ __forceinline__ void operator()(const f32x4 (&acc)[2][2][4][2], const Unit& u, int wr, int wc, int fr, int fq) const {
        const int modid = u.pm < ML / BM ? u.pm / (T / BM) : NB; const float* gp = gate + (size_t)modid * NMODW;
        const int col0 = u.pn * BM + wc * 32 + 4 * fq;
        f32x4 gv[2][2];
#pragma unroll
        for (int bj = 0; bj < 2; ++bj)
#pragma unroll
            for (int n = 0; n < 2; ++n) gv[bj][n] = *(const f32x4*)(gp + col0 + bj * HALF + n * 16) * gs;
        if (u.flags & 1) {
            if (gs != 0.f) { float* sp = slab + ((size_t)(u.flags >> 1) * MC + (size_t)(u.pm - ML / BM) * BM) * D;
#pragma unroll
                for (int ai = 0; ai < 2; ++ai)
#pragma unroll
                    for (int m = 0; m < 4; ++m) { const size_t off = (size_t)(ai * HALF + wr * 64 + m * 16 + fr) * D + col0;
#pragma unroll
                        for (int bj = 0; bj < 2; ++bj)
#pragma unroll
                            for (int n = 0; n < 2; ++n) *(f32x4*)(sp + off + bj * HALF + n * 16) = gv[bj][n] * acc[ai][bj][m][n]; } }
            return; }
        const float* bp = u.pm < ML / BM ? base_lat + (size_t)u.pm * BM * D : base_ctx + (size_t)(u.pm - ML / BM) * BM * D;
        float* op = out + (size_t)u.pm * BM * D;
#pragma unroll
        for (int ai = 0; ai < 2; ++ai)
#pragma unroll
            for (int m = 0; m < 4; ++m) { const size_t off = (size_t)(ai * HALF + wr * 64 + m * 16 + fr) * D + col0;
#pragma unroll
                for (int bj = 0; bj < 2; ++bj)
#pragma unroll
                    for (int n = 0; n < 2; ++n) *(f32x4*)(op + off + bj * HALF + n * 16) = *(const f32x4*)(bp + off + bj * HALF + n * 16) + gv[bj][n] * acc[ai][bj][m][n]; }
    }
};

template <class Epi, class Sched, bool ALIGN_EPI>
__device__ __forceinline__ void gemm_phase(PG8_LAS unsigned char* lds, const Gemm g, const Sched& S, const Epi& E) {
    const int tid = threadIdx.x, wid = __builtin_amdgcn_readfirstlane(tid >> 6), lane = tid & 63, wr = wid >> 2, wc = wid & 3, fr = lane & 15, fq = lane >> 4;
    unsigned voffA[2], voffB[2];
#pragma unroll
    for (int i = 0; i < 2; ++i) { int R, C; stage_rc(tid * 16 + i * 8192, R, C); const int Rb = Epi::PERM ? ((R & ~31) + perm32(R & 31)) : R;
        voffA[i] = (unsigned)(R * g.lda + C) * 2u; voffB[i] = (unsigned)((g.bmap ? 64 * (Rb & 63) + (Rb >> 6) : Rb) * g.ldb + C) * 2u; }
    const size_t kstepA = (size_t)g.ksA, kstepB = (size_t)g.ksB;
    const size_t hstepA = (size_t)HALF * g.lda * 2, hstepB = (size_t)(g.bmap ? 2 : HALF) * g.ldb * 2;
    const unsigned ldsw = (unsigned)wid * 1024u;
    const int aoff = lds_byte(wr * 64 + fr, fq * 8), boff = lds_byte(wc * 32 + fr, fq * 8);
#define PG8_SA(b, h) (((b) * 2 + (h)) * HTB)
#define PG8_SB(b, h) ((4 + (b) * 2 + (h)) * HTB)
#define PG8_STAGE(bufoff, gbase, voff) do { _Pragma("unroll") for (int _i = 0; _i < 2; ++_i) \
        __builtin_amdgcn_global_load_lds((const unsigned*)((const char*)(gbase) + (voff)[_i]), (PG8_LAS unsigned*)(lds + (bufoff) + ldsw + _i * 8192), 16, 0, 0); } while (0)
#define PG8_LDA(dst, b, h) do { _Pragma("unroll") for (int m = 0; m < 4; ++m) _Pragma("unroll") for (int k = 0; k < 2; ++k) dst[m][k] = *(const PG8_LAS bf16x8*)(lds + PG8_SA(b, h) + aoff + m * 2048 + k * 1024); } while (0)
#define PG8_LDB(dst, b, h) do { _Pragma("unroll") for (int n = 0; n < 2; ++n) _Pragma("unroll") for (int k = 0; k < 2; ++k) dst[n][k] = *(const PG8_LAS bf16x8*)(lds + PG8_SB(b, h) + boff + n * 2048 + k * 1024); } while (0)
#define PG8_MMA(ai, bj, At, Bt) do { __builtin_amdgcn_s_setprio(1); _Pragma("unroll") for (int m = 0; m < 4; ++m) _Pragma("unroll") for (int n = 0; n < 2; ++n) _Pragma("unroll") for (int k = 0; k < 2; ++k) \
        acc[ai][bj][m][n] = __builtin_amdgcn_mfma_f32_16x16x32_bf16(Bt[n][k], At[m][k], acc[ai][bj][m][n], 0, 0, 0); __builtin_amdgcn_s_setprio(0); } while (0)
#define PG8_WAIT_V(n) asm volatile("s_waitcnt vmcnt(" #n ")" ::: "memory")
#define PG8_WAIT_L(n) asm volatile("s_waitcnt lgkmcnt(" #n ")" ::: "memory")
#define PG8_BAR __builtin_amdgcn_s_barrier()
#define PG8_SCHED __builtin_amdgcn_sched_barrier(0)
    Unit cur, nxt; int ui = 0;
    if (!S.next(0, cur)) return;
    f32x4 acc[2][2][4][2];
#pragma unroll
    for (int a = 0; a < 2; ++a)
#pragma unroll
        for (int b = 0; b < 2; ++b)
#pragma unroll
            for (int m = 0; m < 4; ++m)
#pragma unroll
                for (int n = 0; n < 2; ++n) acc[a][b][m][n] = (f32x4){0.f, 0.f, 0.f, 0.f};
    bf16x8 At[4][2], B0[2][2], B1[2][2];
    const char* cA = cur.a; const char* cB = cur.b;
    PG8_STAGE(PG8_SB(0, 0), cB, voffB); PG8_STAGE(PG8_SB(0, 1), cB + hstepB, voffB); PG8_STAGE(PG8_SA(0, 0), cA, voffA); PG8_STAGE(PG8_SA(0, 1), cA + hstepA, voffA);
    if (wr == 1) PG8_BAR;
    PG8_WAIT_V(2); PG8_BAR;
    PG8_STAGE(PG8_SB(1, 0), cB + kstepB, voffB); PG8_STAGE(PG8_SA(1, 0), cA + kstepA, voffA); PG8_STAGE(PG8_SB(1, 1), cB + hstepB + kstepB, voffB);
    PG8_WAIT_V(6); PG8_BAR;
    for (;;) {
        int nt = cur.nt; asm volatile("" : "+s"(nt));
        const bool has_next = S.next(ui + 1, nxt);
        const char* nA = has_next ? nxt.a : cA; const char* nB = has_next ? nxt.b : cB;
        for (int t = 0; t < nt; t += 2) {
            const bool last = (t == nt - 2);
            const char* a1 = cA + (size_t)(t + 1) * kstepA;
            const char* a2 = last ? nA : cA + (size_t)(t + 2) * kstepA; const char* b2 = last ? nB : cB + (size_t)(t + 2) * kstepB;
            const char* a3 = a2 + kstepA; const char* b3 = b2 + kstepB;
            PG8_LDB(B0, 0, 0); PG8_LDB(B1, 0, 1); PG8_SCHED; PG8_LDA(At, 0, 0); PG8_STAGE(PG8_SA(1, 1), a1 + hstepA, voffA);
            PG8_WAIT_V(8); PG8_WAIT_L(0); PG8_BAR; PG8_MMA(0, 0, At, B0); PG8_MMA(0, 1, At, B1); PG8_BAR; PG8_SCHED;
            PG8_LDA(At, 0, 1); PG8_STAGE(PG8_SB(0, 0), b2, voffB); PG8_STAGE(PG8_SB(0, 1), b2 + hstepB, voffB); PG8_STAGE(PG8_SA(0, 0), a2, voffA);
            PG8_WAIT_V(8); PG8_WAIT_L(0); PG8_BAR; PG8_MMA(1, 0, At, B0); PG8_MMA(1, 1, At, B1); PG8_BAR; PG8_SCHED;
            PG8_LDB(B0, 1, 0); PG8_LDB(B1, 1, 1); PG8_SCHED; PG8_LDA(At, 1, 0); PG8_STAGE(PG8_SA(0, 1), a2 + hstepA, voffA);
            PG8_WAIT_V(8); PG8_WAIT_L(0); PG8_BAR; PG8_MMA(0, 0, At, B0); PG8_MMA(0, 1, At, B1); PG8_BAR; PG8_SCHED;
            PG8_LDA(At, 1, 1); PG8_STAGE(PG8_SB(1, 0), b3, voffB); PG8_STAGE(PG8_SB(1, 1), b3 + hstepB, voffB); PG8_STAGE(PG8_SA(1, 0), a3, voffA);
            PG8_WAIT_V(8); PG8_WAIT_L(0); PG8_BAR; PG8_MMA(1, 0, At, B0); PG8_MMA(1, 1, At, B1); PG8_BAR; PG8_SCHED;
        }
        if constexpr (ALIGN_EPI) { if (wr == 0) PG8_BAR; }
        E(acc, cur, wr, wc, fr, fq);
        if (!has_next) break;
#pragma unroll
        for (int a = 0; a < 2; ++a)
#pragma unroll
            for (int b = 0; b < 2; ++b)
#pragma unroll
                for (int m = 0; m < 4; ++m)
#pragma unroll
                    for (int n = 0; n < 2; ++n) acc[a][b][m][n] = (f32x4){0.f, 0.f, 0.f, 0.f};
        cur = nxt; cA = nA; cB = nB; ++ui;
        if constexpr (ALIGN_EPI) { if (wr == 1) PG8_BAR; }
    }
    PG8_WAIT_V(0);
    if constexpr (!ALIGN_EPI) { if (wr == 0) PG8_BAR; }
    PG8_BAR;
#undef PG8_SA
#undef PG8_SB
#undef PG8_STAGE
#undef PG8_LDA
#undef PG8_LDB
#undef PG8_MMA
#undef PG8_WAIT_V
#undef PG8_WAIT_L
#undef PG8_BAR
#undef PG8_SCHED
}
}

#define XB_TMO      128
#define XB_XCNT(j)  (256  + 64 * (j))
#define XB_XSUB(j)  (1280 + 64 * (j))
#define XB_XGEN(j)  (2304 + 64 * (j))
#define XB_TOP      3328
#define XB_TOPGEN   3392
#define XCD_BAR_WORDS 3456
#define XB_SPIN_CAP (1u << 22)
__device__ __forceinline__ unsigned xb_ld(unsigned* p)              { return __hip_atomic_load(p, __ATOMIC_RELAXED, __HIP_MEMORY_SCOPE_AGENT); }
__device__ __forceinline__ unsigned xb_add(unsigned* p, unsigned v) { return __hip_atomic_fetch_add(p, v, __ATOMIC_RELAXED, __HIP_MEMORY_SCOPE_AGENT); }
__device__ __forceinline__ unsigned xb_xcc_id() { return (unsigned)__builtin_amdgcn_s_getreg((3 << 11) | 20) & 0xFu; }
#define XB_SPIN(cond, bar) do { unsigned _sp = 0; while (cond) { __builtin_amdgcn_s_sleep(1); \
    if ((++_sp & 255u) == 0u) { if (xb_ld(&(bar)[XB_TMO])) break; if (_sp > XB_SPIN_CAP) { atomicAdd(&(bar)[XB_TMO], 1u); break; } } } } while (0)
struct XcdBarrier { unsigned* bar; unsigned x; volatile LAS unsigned* st; };
__device__ __forceinline__ XcdBarrier xcd_barrier_post(unsigned* bar, volatile LAS unsigned* st) {
    XcdBarrier b; b.bar = bar; b.x = xb_xcc_id(); b.st = st;
    if (threadIdx.x == 0) (void)xb_add(&bar[XB_XCNT(b.x)], 1u);
    return b;
}
__device__ __forceinline__ void xcd_barrier_complete(unsigned* bar, unsigned x, unsigned& nloc, unsigned& nx) {
    const unsigned G = gridDim.x * gridDim.y * gridDim.z;
    unsigned sum, cnt, mine, sp = 0u;
    for (;;) {
        sum = 0u; cnt = 0u; mine = 0u;
#pragma unroll
        for (unsigned j = 0; j < 16; ++j) { const unsigned c = xb_ld(&bar[XB_XCNT(j)]); sum += c; cnt += (c > 0u) ? 1u : 0u; mine = (j == x) ? c : mine; }
        if (sum == G) break;
        __builtin_amdgcn_s_sleep(1);
        if ((++sp & 255u) == 0u) { if (xb_ld(&bar[XB_TMO])) break; if (sp > XB_SPIN_CAP) { atomicAdd(&bar[XB_TMO], 1u); break; } }
    }
    nloc = mine > 0u ? mine : 1u; nx = cnt > 0u ? cnt : 1u;
}
__device__ __forceinline__ void xcd_barrier(const XcdBarrier& b) {
    asm volatile("s_waitcnt vmcnt(0)" ::: "memory");
    __syncthreads();
    if (threadIdx.x == 0) {
        unsigned* bar = b.bar;
        __builtin_amdgcn_s_waitcnt(0);
        unsigned nloc = b.st[0], nx = b.st[1];
        if (nloc == 0u) { xcd_barrier_complete(bar, b.x, nloc, nx); b.st[0] = nloc; b.st[1] = nx; }
        const unsigned old = xb_add(&bar[XB_XSUB(b.x)], 1u);
        const unsigned gen = old / nloc;
        if (old + 1u == (gen + 1u) * nloc) {
            __builtin_amdgcn_fence(__ATOMIC_RELEASE, "agent");
            asm volatile("s_waitcnt vmcnt(0)" ::: "memory");
            const unsigned og = xb_add(&bar[XB_TOP], 1u);
            const unsigned tg = og / nx;
            if (og + 1u == (tg + 1u) * nx) xb_add(&bar[XB_TOPGEN], 1u);
            else XB_SPIN(xb_ld(&bar[XB_TOPGEN]) == tg, bar);
            __builtin_amdgcn_fence(__ATOMIC_ACQUIRE, "agent");
            xb_add(&bar[XB_XGEN(b.x)], 1u);
            asm volatile("s_waitcnt vmcnt(0)" ::: "memory");
        } else {
            XB_SPIN(xb_ld(&bar[XB_XGEN(b.x)]) == gen, bar);
            __builtin_amdgcn_fence(__ATOMIC_ACQUIRE, "agent");
            asm volatile("s_waitcnt vmcnt(0)" ::: "memory");
        }
    }
    __syncthreads();
}

constexpr int NWAVES = 8, NTHR = 512;
constexpr int RING_BYTES = 131072, MISC_OFF = RING_BYTES + 320, LDS_BYTES = 147456;
struct Args { const float* in[33]; float* out; unsigned char* ws; int ph_lo, ph_hi, rep, li; };
typedef const __attribute__((address_space(4))) Args* ArgP;
enum { I_X = 0, I_C = 1, I_CTX = 2, I_CCTX = 3, I_L0 = 4, I_WIN = 13, I_GWF = 14, I_GBF = 15, I_GWB = 16, I_GBB = 17, I_GNORM = 18, I_WOUT0 = 19, I_L1 = 20, I_WQKV = 29, I_RPB = 30, I_WOUT1 = 31, I_NOUT = 32 };

struct Ctx { unsigned char* lds; int tid, lane, wave, bx, G, gw, NGW; };

__device__ __forceinline__ void ada_units(ArgP a, const Ctx& c) {
    float* MODS = (float*)(a->ws + WS_MODS); float* red = (float*)c.lds;
    for (int u = c.bx; u < 2 * 72 * 16; u += c.G) {
        const int l = u / 1152, rem = u % 1152, nb = rem >> 4, kc = rem & 15;
        const float* W = a->in[l ? I_L1 : I_L0]; const float* bias = a->in[(l ? I_L1 : I_L0) + 1];
        const int n0 = nb * 256 + 4 * c.lane, k0 = kc * 128 + c.wave * 16;
        f32x4 w[16];
#pragma unroll
        for (int kk = 0; kk < 16; ++kk) w[kk] = *(const f32x4*)(W + (size_t)(k0 + kk) * NMODW + n0);
        float sv[5];
#pragma unroll
        for (int i = 0; i < 5; ++i) { const float* cv = i < 4 ? a->in[I_C] + i * D : a->in[I_CCTX]; sv[i] = silu_f(cv[k0 + (c.lane & 15)]); }
        f32x4 acc[5];
#pragma unroll
        for (int i = 0; i < 5; ++i) acc[i] = (f32x4){0.f, 0.f, 0.f, 0.f};
#pragma unroll
        for (int kk = 0; kk < 16; ++kk)
#pragma unroll
            for (int i = 0; i < 5; ++i) acc[i] += rdl(sv[i], kk) * w[kk];
#pragma unroll
        for (int i = 0; i < 5; ++i) *(f32x4*)(red + (c.wave * 5 + i) * 256 + 4 * c.lane) = acc[i];
        __syncthreads();
        for (int e = c.tid; e < 1280; e += NTHR) { const int i = e >> 8, n = e & 255; float sum = 0.f;
#pragma unroll
            for (int ww = 0; ww < 8; ++ww) sum += red[(ww * 5 + i) * 256 + n];
            if (kc == 0) sum += bias[nb * 256 + n];
            unsafeAtomicAdd(MODS + (size_t)(l * 5 + i) * NMODW + nb * 256 + n, sum); }
        __syncthreads();
    }
}
__device__ __forceinline__ void tables(ArgP a, const Ctx& c) {
    const int gt = c.bx * NTHR + c.tid, NT = c.G * NTHR;
    bf16* WA = (bf16*)(a->ws + WS_WA); bf16* WB = (bf16*)(a->ws + WS_WB);
    for (int it = gt; it < 2 * 256 * 16; it += NT) { const int wsel = it >> 12, row = (it >> 4) & 255, c0 = (it & 15) * 8, ri = c0 >> 6, t0 = c0 & 63, ai = row >> 7, rr = row & 127; float v[8];
#pragma unroll
        for (int j = 0; j < 8; ++j) { const float x = (float)(((t0 + j) * rr) & 63) * (1.f / 32.f), cs = cospif(x), sn = sinpif(x);
            v[j] = rr >= 64 ? 0.f : (wsel == 0 ? (ai == 0 ? (ri ? -sn : cs) : (ri ? cs : sn)) : (ai == 0 ? (ri ? -sn : cs) * (1.f / 1024.f) : 0.f)); }
        u32x4 w; w.x = pk2(v[0], v[1]); w.y = pk2(v[2], v[3]); w.z = pk2(v[4], v[5]); w.w = pk2(v[6], v[7]); *(u32x4*)((wsel ? WB : WA) + row * 128 + c0) = w; }
    f32x2* TWt = (f32x2*)(a->ws + WS_TW);
    for (int it = gt; it < 64 * 64; it += NT) { const float x = (float)(((it >> 6) * (it & 63)) & 4095) * (1.f / 2048.f); TWt[it] = (f32x2){cospif(x), sinpif(x)}; }
    bf16* DC = (bf16*)(a->ws + WS_DFTC);
    for (int it = gt; it < 512 * 32; it += NT) { const int row = it >> 5, c0 = (it & 31) * 8, cs = row >> 8, cp = row & 255; float v[8];
#pragma unroll
        for (int j = 0; j < 8; ++j) { const int idx = ((c0 + j) * cp) & 255; const float x = (float)idx * (1.f / 128.f); v[j] = cs ? sinpif(x) : cospif(x); }
        u32x4 w; w.x = pk2(v[0], v[1]); w.y = pk2(v[2], v[3]); w.z = pk2(v[4], v[5]); w.w = pk2(v[6], v[7]); *(u32x4*)(DC + (size_t)row * 256 + c0) = w; }
    bf16* D2 = (bf16*)(a->ws + WS_DFT256);
    for (int it = gt; it < 256 * 64; it += NT) { const int tp = it >> 6, c0 = (it & 63) * 8, cs = c0 >> 8, t0 = c0 & 255; float v[8];
#pragma unroll
        for (int j = 0; j < 8; ++j) { const int idx = ((t0 + j) * tp) & 255; const float x = (float)idx * (1.f / 128.f); v[j] = (cs ? -sinpif(x) : cospif(x)) * (1.f / 256.f); }
        u32x4 w; w.x = pk2(v[0], v[1]); w.y = pk2(v[2], v[3]); w.z = pk2(v[4], v[5]); w.w = pk2(v[6], v[7]); *(u32x4*)(D2 + (size_t)tp * 512 + c0) = w; }
    f32x2* RP = (f32x2*)(a->ws + WS_ROPE);
    for (int it = gt; it < 64 * 32; it += NT) { const int pos = it >> 5, i = it & 31; const float inv = powf(10000.f, -(float)i / 32.f), ang = (float)pos * inv; RP[it] = (f32x2){cosf(ang), sinf(ang)}; }
}

__device__ __forceinline__ int src_col0(int type, int n0) {
    if (type == 1) { const int pn = n0 >> 8, rem = n0 & 255, bj = rem >> 7, j = rem & 127; return bj * FF + pn * 128 + j; }
    if (type == 2) { return n0 < 2048 ? n0 : (n0 < 4096 ? n0 + 32 : (n0 == 4096 ? 2048 : -1)); }
    return n0;
}
__device__ __forceinline__ void tr_load(f32x4 (&v)[8], const float* W, int Nsrc, int sn0, int k0, int lane) {
    const float* p = W + (size_t)(k0 + 8 * (lane >> 3)) * Nsrc + sn0 + 4 * (lane & 7);
#pragma unroll
    for (int j = 0; j < 8; ++j) v[j] = sn0 >= 0 ? *(const f32x4*)(p + (size_t)j * Nsrc) : (f32x4){0.f, 0.f, 0.f, 0.f};
}
__device__ __forceinline__ void tr_store(const f32x4 (&v)[8], bf16* WT, int K, int dn0, int k0, int lane) {
    const int n = dn0 + 4 * (lane & 7); bf16* p = WT + (((size_t)(n >> 8) * (K >> 6) + (k0 >> 6)) * 256 + (n & 255)) * 64 + 8 * (lane >> 3);
#pragma unroll
    for (int e = 0; e < 4; ++e) { u32x4 o; o.x = pk2(v[0][e], v[1][e]); o.y = pk2(v[2][e], v[3][e]); o.z = pk2(v[4][e], v[5][e]); o.w = pk2(v[6][e], v[7][e]); *(u32x4*)(p + (size_t)e * 64) = o; }
}
__device__ __forceinline__ void convert_matrix(const float* W, int K, int Nsrc, int Ndst, int type, bf16* WT, const Ctx& c) {
    const int nblk = Ndst / 32, nitems = (K / 64) * nblk;
    for (int it = c.gw; it < nitems; it += 2 * c.NGW) { const int it2 = it + c.NGW; const bool two = it2 < nitems;
        const int kb = it / nblk, nb = it % nblk, kb2 = two ? it2 / nblk : kb, nb2 = two ? it2 % nblk : nb;
        f32x4 v0[8], v1[8];
        tr_load(v0, W, Nsrc, src_col0(type, nb * 32), kb * 64, c.lane); tr_load(v1, W, Nsrc, src_col0(type, nb2 * 32), kb2 * 64, c.lane);
        tr_store(v0, WT, K, nb * 32, kb * 64, c.lane); if (two) tr_store(v1, WT, K, nb2 * 32, kb2 * 64, c.lane); }
}
__device__ __forceinline__ void convert_layer(ArgP a, const Ctx& c, int l) {
    const int base = l ? I_L1 : I_L0;
    convert_matrix(a->in[base + 5], D, 2 * FF, 2 * FF, 1, (bf16*)(a->ws + W_GU1), c);
    convert_matrix(a->in[base + 7], D, 2 * FF, 2 * FF, 1, (bf16*)(a->ws + W_GU2), c);
    convert_matrix(a->in[base + 6], FF, D, D, 0, (bf16*)(a->ws + W_D1), c);
    convert_matrix(a->in[base + 8], FF, D, D, 0, (bf16*)(a->ws + W_D2), c);
    if (l == 0) convert_matrix(a->in[I_WIN], D, 4128, ZW, 2, (bf16*)(a->ws + W_MIXA), c);
    else        convert_matrix(a->in[I_WQKV], D, QW, QW, 0, (bf16*)(a->ws + W_MIXA), c);
    convert_matrix(a->in[l ? I_WOUT1 : I_WOUT0], D, D, D, 0, (bf16*)(a->ws + W_OUT), c);
}

__device__ __forceinline__ void norm_row(const float* xr, bf16* Ub, int row, const f32x4 (&ca)[8], const f32x4 (&cb)[8], int lane) {
    f32x4 v[8]; float s = 0.f;
#pragma unroll
    for (int j = 0; j < 8; ++j) { v[j] = *(const f32x4*)(xr + 4 * lane + 256 * j); s += (v[j].x * v[j].x + v[j].y * v[j].y) + (v[j].z * v[j].z + v[j].w * v[j].w); }
    const float rstd = 1.f / sqrtf(wave_sum(s) * (1.f / D) + RMS_EPS);
#pragma unroll
    for (int j = 0; j < 8; ++j) { const f32x4 o = v[j] * rstd * ca[j] + cb[j]; u32x2 w; w.x = pk2(o.x, o.y); w.y = pk2(o.z, o.w); const int k = 4 * lane + 256 * j;
        *(u32x2*)(Ub + (((size_t)(row >> 8) * (D / 64) + (k >> 6)) * 256 + (row & 255)) * 64 + (k & 63)) = w; }
}
__device__ __forceinline__ void norm_mod_phase(const Ctx& c, const float* lat, const float* ctx, const float* gain, const float* mods, int jsub, bf16* U, bool with_ctx, float* ctx_copy, const float* slabs) {
    for (int vb = c.bx; vb < 256; vb += c.G) {
        f32x4 ca[8], cb[8];
        { const float* sh = mods + (size_t)(vb >> 6) * NMODW + (3 * jsub) * D; const float* sc = sh + D;
#pragma unroll
          for (int j = 0; j < 8; ++j) { const int k = 4 * c.lane + 256 * j; ca[j] = *(const f32x4*)(gain + k) * (*(const f32x4*)(sc + k) + 1.f); cb[j] = *(const f32x4*)(sh + k); } }
        for (int r = 0; r < 8; ++r) { const int row = 64 * vb + 8 * c.wave + r; norm_row(lat + (size_t)row * D, U, row, ca, cb, c.lane); }
        if (with_ctx && c.wave < 4) {
            const float* sh = mods + (size_t)NB * NMODW + (3 * jsub) * D; const float* sc = sh + D;
#pragma unroll
            for (int j = 0; j < 8; ++j) { const int k = 4 * c.lane + 256 * j; ca[j] = *(const f32x4*)(gain + k) * (*(const f32x4*)(sc + k) + 1.f); cb[j] = *(const f32x4*)(sh + k); }
            const int row = 4 * vb + c.wave; float* xr = (float*)ctx + (size_t)row * D;
            if (slabs) {
#pragma unroll
                for (int j = 0; j < 8; ++j) { const size_t o = (size_t)row * D + 4 * c.lane + 256 * j; f32x4 v = *(const f32x4*)(ctx + o);
#pragma unroll
                    for (int q = 0; q < 4; ++q) v += *(const f32x4*)(slabs + (size_t)q * MC * D + o);
                    *(f32x4*)(xr + 4 * c.lane + 256 * j) = v; }
                asm volatile("s_waitcnt vmcnt(0)" ::: "memory"); }
            norm_row(ctx + (size_t)row * D, U, ML + row, ca, cb, c.lane);
            if (ctx_copy) {
#pragma unroll
                for (int j = 0; j < 8; ++j) *(f32x4*)(ctx_copy + (size_t)row * D + 4 * c.lane + 256 * j) = *(const f32x4*)(ctx + (size_t)row * D + 4 * c.lane + 256 * j); }
        }
    }
}

struct Fn1Sched {
    int G, c; const char* dftc; const char* Z;
    __device__ __forceinline__ bool next(int i, pg8::Unit& u) const {
        const int L = i * G + c; if (L >= 512) return false;
        u.pm = 0; u.pn = 0; u.sc = 1.f; u.nt = 4; u.flags = 8;
        const int j = L & 15, ri = (L >> 4) & 1, g = (L >> 5) & 3, b = L >> 7;
        u.a = dftc + (size_t)ri * 256 * 256 * 2; u.b = Z + ((size_t)(b * T + 4 * j) * ZW + 3072 + g * 256) * 2;
        u.ooff = (long)((size_t)(b * 1024 + g * 256) * 8192 + 4 * j * 128 + ri * 64); u.ldc = 8192; return true;
    }
};
struct Fn1cSched {
    int G, c; const char* dftc; const char* Z;
    __device__ __forceinline__ bool next(int i, pg8::Unit& u) const {
        const int L = i * G + c; if (L >= 32) return false;
        u.pm = 0; u.pn = 0; u.sc = 1.f; u.nt = 4; u.flags = 0;
        const int cs = L & 1, g = (L >> 1) & 3, b = L >> 3;
        u.a = dftc + (size_t)cs * 256 * 256 * 2; u.b = Z + ((size_t)(ML + b * TC) * ZW + 3072 + g * 256) * 2;
        u.ooff = (long)((WS_F1TC - WS_F1T) / 2 + (size_t)(b * 1024 + g * 256) * 512 + cs * 256); u.ldc = 512; return true;
    }
};
struct FabSched {
    int G, c; const char* w; const char* x;
    __device__ __forceinline__ bool next(int i, pg8::Unit& u) const {
        const int L = i * G + c; if (L >= 1024) return false;
        u.pm = 0; u.pn = L; u.sc = 1.f; u.nt = 2; u.flags = 0; u.ooff = 0; u.ldc = 0; u.a = w; u.b = x + (size_t)L * 256 * 128 * 2; return true;
    }
};
struct Fn2cSched {
    int G, c; const char* dft; const char* f1tc;
    __device__ __forceinline__ bool next(int i, pg8::Unit& u) const {
        const int L = i * G + c; if (L >= 16) return false;
        const int b = L >> 2, pn = L & 3;
        u.pm = 0; u.pn = pn; u.sc = 1.f; u.nt = 8; u.flags = 0; u.a = dft; u.b = f1tc + (size_t)(b * 1024 + pn * 256) * 512 * 2;
        u.ooff = (long)((size_t)(ML + b * TC) * D + 1024 + pn * 256); u.ldc = D; return true;
    }
};
struct StoreSched {
    pg8::PlainSched p; int ldc, nscale; float sc0;
    __device__ __forceinline__ bool next(int i, pg8::Unit& u) const { if (!p.next(i, u)) return false; u.ooff = (long)((size_t)u.pm * 256 * ldc + u.pn * 256); u.ldc = ldc; u.sc = u.pn < nscale ? sc0 : 1.f; return true; }
};

struct ResidSched {
    pg8::TileOrder to; int G, c, ntk, npieces, ksa; const char* A; const char* Bt; size_t a_t, b_t;
    __device__ __forceinline__ void init(const void* A_, int lda, const void* Bt_, int ldb, int K, bool with_ctx, int G_, int c_, int ksa_ = 128) { ksa = ksa_; to.init(ML / 256, 8); G = G_; c = c_; ntk = K / 64; npieces = with_ctx ? 128 : 0;
        A = (const char*)A_; Bt = (const char*)Bt_; a_t = (size_t)256 * lda * 2; b_t = (size_t)256 * ldb * 2; }
    __device__ __forceinline__ bool next(int i, pg8::Unit& u) const {
        const int L = i * G + c; u.ooff = 0; u.ldc = 0; u.sc = 1.f;
        if (L < 512) { to.decode(L, u.pm, u.pn); u.a = A + (size_t)u.pm * a_t; u.b = Bt + (size_t)u.pn * b_t; u.nt = ntk; u.flags = 0; return true; }
        const int piece = L - 512; if (piece >= npieces) return false;
        const int idx = piece >> 3, pair = (piece & 7) * 2 + (idx >> 3), kq = pair & 3, ntp = ntk >> 2;
        u.pn = idx & 7; u.pm = ML / 256 + (pair >> 2); u.nt = ntp; u.flags = 1 | (kq << 1);
        u.a = A + (size_t)u.pm * a_t + (size_t)kq * ntp * ksa; u.b = Bt + (size_t)u.pn * b_t + (size_t)kq * ntp * 32768; return true;
    }
};
struct QkvSched {
    int G, c; const char* U; const char* W;
    __device__ __forceinline__ bool next(int i, pg8::Unit& u) const {
        int L = i * G + c; if (L >= 1632) return false;
        u.nt = D / 64; u.flags = 0;
        if (L < 1088) { pg8::TileOrder to; to.init(MT / 256, 16); to.decode(L, u.pm, u.pn); u.a = U + (size_t)u.pm * 256 * D * 2; u.b = W + (size_t)u.pn * 256 * D * 2;
            u.ooff = 0; u.ldc = 0; u.sc = u.pn < 8 ? 0.125f * 1.4426950408889634f : 1.f; }
        else { L -= 1088; pg8::TileOrder to; to.init(8, MT / 256); to.decode(L, u.pm, u.pn); u.a = W + (size_t)(16 + u.pm) * 256 * D * 2; u.b = U + (size_t)u.pn * 256 * D * 2;
            u.ooff = 0; u.ldc = 0; u.sc = 1.f; u.flags = 2; }
        return true;
    }
};

typedef float f32x16 __attribute__((ext_vector_type(16)));
#define MFMA32(a, b, c) __builtin_amdgcn_mfma_f32_32x32x16_bf16((a), (b), (c), 0, 0, 0)
constexpr int GLA_NC = 68, GLA_UNITS = 16 * GLA_NC;
__device__ __forceinline__ int gla_row0(int b, int cn) { return cn < 4 ? ML + b * TC + cn * 64 : b * T + (cn - 4) * 64; }
__device__ __forceinline__ float logsig16(float x) { return (fminf(x, 0.f) - 0.6931471805599453f * __builtin_amdgcn_logf(1.f + __expf(-fabsf(x)))) * (1.f / 16.f); }
__device__ __forceinline__ void gla_a_phase(ArgP a, const Ctx& c) {
    unsigned char* L = c.lds;
    float* LR = (float*)L; float* TOT = (float*)(L + 8192);
    bf16* QF = (bf16*)(L + 12288); bf16* KF = QF + 64 * 136; bf16* QB = KF + 64 * 136; bf16* KB = QB + 64 * 136;
    bf16* K2TF = (bf16*)(L + 81920); bf16* K2TB = (bf16*)(L + 100352);
    bf16* VT = (bf16*)(L + 12288);
    const bf16* Z = (const bf16*)(a->ws + WS_BIG); const f32x2* RP = (const f32x2*)(a->ws + WS_ROPE);
    bf16* QP = (bf16*)(a->ws + WS_QP); bf16* ATT = (bf16*)(a->ws + WS_ATT); bf16* DST = (bf16*)(a->ws + WS_DST); float* AD = (float*)(a->ws + WS_AD);
    const int kk = c.tid & 127, grp = c.tid >> 7, l32 = c.lane & 31, hh = c.lane >> 5;
    float wf[16], wb[16], biasf = 0.f, biasb = 0.f; u32x4 qkraw[4]; bf16 lrv[4]; bf16x8 vraw[4];
#define GLA_A_LOADS(UU) do { const int u_ = (UU), bh_ = u_ / GLA_NC, cn_ = u_ % GLA_NC, h_ = bh_ & 3, row0_ = gla_row0(bh_ >> 2, cn_); \
        _Pragma("unroll") for (int i = 0; i < 4; ++i) { const int e = c.tid + 512 * i; lrv[i] = Z[(size_t)(row0_ + (e >> 5)) * ZW + 4096 + (e & 31)]; } \
        _Pragma("unroll") for (int j = 0; j < 16; ++j) { wf[j] = a->in[I_GWF][j * 512 + h_ * 128 + kk]; wb[j] = a->in[I_GWB][j * 512 + h_ * 128 + kk]; } \
        _Pragma("unroll") for (int i = 0; i < 2; ++i) { const int ch = c.tid + 512 * i; const bf16* z = Z + (size_t)(row0_ + (ch >> 4)) * ZW + h_ * 128 + (ch & 15) * 8; qkraw[i] = *(const u32x4*)z; qkraw[2 + i] = *(const u32x4*)(z + 512); } \
        _Pragma("unroll") for (int i = 0; i < 4; ++i) { const int p = c.tid + 512 * i; vraw[i] = *(const bf16x8*)(Z + (size_t)(row0_ + (p & 7) + 8 * (p >> 8)) * ZW + 1024 + h_ * 256 + ((p >> 3) & 31) * 8); }     \
        biasf = a->in[I_GBF][h_ * 128 + kk]; biasb = a->in[I_GBB][h_ * 128 + kk]; } while (0)
    const float invf = __builtin_amdgcn_exp2f(-(float)(kk & 31) * (13.287712379549449f / 32.f)) * 0.15915494309189535f;
    if (c.bx < GLA_UNITS) GLA_A_LOADS(c.bx);
    for (int u = c.bx; u < GLA_UNITS; u += c.G) {
        const int bh = u / GLA_NC, cn = u % GLA_NC, b = bh >> 2, h = bh & 3, row0 = gla_row0(b, cn);
#pragma unroll
        for (int i = 0; i < 4; ++i) LR[c.tid + 512 * i] = bf2f(lrv[i]);
#pragma unroll
        for (int i = 0; i < 2; ++i) { const int ch = c.tid + 512 * i, o = (ch >> 4) * 136 + (ch & 15) * 8; *(u32x4*)(QF + o) = qkraw[i]; *(u32x4*)(KF + o) = qkraw[2 + i]; }
        __syncthreads();
        float gf[16], gb[16];
#pragma unroll
        for (int i = 0; i < 16; ++i) { const float* lr = LR + (16 * grp + i) * 32; float pf = biasf, pb = biasb;
#pragma unroll
            for (int j = 0; j < 16; ++j) { pf += lr[j] * wf[j]; pb += lr[16 + j] * wb[j]; }
            gf[i] = logsig16(pf); gb[i] = logsig16(pb); }
#pragma unroll
        for (int i = 1; i < 16; ++i) gf[i] += gf[i - 1];
#pragma unroll
        for (int i = 14; i >= 0; --i) gb[i] += gb[i + 1];
        TOT[grp * 128 + kk] = gf[15]; TOT[(4 + grp) * 128 + kk] = gb[0];
        __syncthreads();
        float offf = 0.f, offb = 0.f, lastf = 0.f, firstb = 0.f;
#pragma unroll
        for (int g = 0; g < 4; ++g) { const float tf = TOT[g * 128 + kk], tb = TOT[(4 + g) * 128 + kk]; lastf += tf; firstb += tb; if (g < grp) offf += tf; if (g > grp) offb += tb; }
        const float Elast = __expf(lastf), Efirst = __expf(firstb);
        float k2f[16], k2b[16];
#pragma unroll
        for (int i = 0; i < 16; ++i) { const int t = 16 * grp + i;
            float qv = bf2f(QF[t * 136 + kk]), kv = bf2f(KF[t * 136 + kk]);
            if (cn >= 4) { float fpos = (float)((kk & 64) ? t : (cn - 4)); asm volatile("" : "+v"(fpos));
                const float ang = fpos * invf; const f32x2 cs = (f32x2){__builtin_amdgcn_cosf(ang), __builtin_amdgcn_sinf(ang)};   const float qo = __shfl_xor(qv, 32), ko = __shfl_xor(kv, 32);
                if (kk & 32) { qv = qo * cs.y + qv * cs.x; kv = ko * cs.y + kv * cs.x; } else { qv = qv * cs.x - qo * cs.y; kv = kv * cs.x - ko * cs.y; } }
            qv *= 0.08838834764831845f;
            const float ef = __expf(gf[i] + offf), eb = __expf(gb[i] + offb), ief = __builtin_amdgcn_rcpf(ef), ieb = __builtin_amdgcn_rcpf(eb);
            const bf16 qf_ = (bf16)f2bf(qv * ef), qb_ = (bf16)f2bf(qv * eb);
            QF[t * 136 + kk] = qf_; KF[t * 136 + kk] = (bf16)f2bf(kv * ief); QB[t * 136 + kk] = qb_; KB[t * 136 + kk] = (bf16)f2bf(kv * ieb);
            QP[((size_t)u * 64 + t) * 256 + kk] = qf_; QP[((size_t)u * 64 + t) * 256 + 128 + kk] = qb_;
            k2f[i] = kv * ief * Elast; k2b[i] = kv * ieb * Efirst; }
        { u32x4 w0, w1;
          w0.x = pk2(k2f[0], k2f[1]); w0.y = pk2(k2f[2], k2f[3]); w0.z = pk2(k2f[4], k2f[5]); w0.w = pk2(k2f[6], k2f[7]); w1.x = pk2(k2f[8], k2f[9]); w1.y = pk2(k2f[10], k2f[11]); w1.z = pk2(k2f[12], k2f[13]); w1.w = pk2(k2f[14], k2f[15]);
          *(u32x4*)(K2TF + kk * 72 + 16 * grp) = w0; *(u32x4*)(K2TF + kk * 72 + 16 * grp + 8) = w1;
          w0.x = pk2(k2b[0], k2b[1]); w0.y = pk2(k2b[2], k2b[3]); w0.z = pk2(k2b[4], k2b[5]); w0.w = pk2(k2b[6], k2b[7]); w1.x = pk2(k2b[8], k2b[9]); w1.y = pk2(k2b[10], k2b[11]); w1.z = pk2(k2b[12], k2b[13]); w1.w = pk2(k2b[14], k2b[15]);
          *(u32x4*)(K2TB + kk * 72 + 16 * grp) = w0; *(u32x4*)(K2TB + kk * 72 + 16 * grp + 8) = w1; }
        if (grp == 0) { AD[((size_t)u * 2 + 0) * 128 + kk] = Elast; AD[((size_t)u * 2 + 1) * 128 + kk] = Efirst; }
        __syncthreads();
        if (c.wave < 4) {
            const int ti = c.wave >> 1, si = c.wave & 1; f32x16 accF, accB;
#pragma unroll
            for (int r = 0; r < 16; ++r) { accF[r] = 0.f; accB[r] = 0.f; }
#pragma unroll
            for (int s = 0; s < 8; ++s) { const int ko = 16 * s + 8 * hh;
                accF = MFMA32(*(const bf16x8*)(KF + (32 * si + l32) * 136 + ko), *(const bf16x8*)(QF + (32 * ti + l32) * 136 + ko), accF);
                accB = MFMA32(*(const bf16x8*)(KB + (32 * si + l32) * 136 + ko), *(const bf16x8*)(QB + (32 * ti + l32) * 136 + ko), accB); }
            const int t = 32 * ti + l32;
#pragma unroll
            for (int g = 0; g < 4; ++g) { float v[4];
#pragma unroll
                for (int e = 0; e < 4; ++e) { const int s_ = 32 * si + 8 * g + 4 * hh + e; v[e] = (s_ <= t ? accF[4 * g + e] : 0.f) + (s_ >= t ? accB[4 * g + e] : 0.f); }
                u32x2 w; w.x = pk2(v[0], v[1]); w.y = pk2(v[2], v[3]); *(u32x2*)(ATT + ((size_t)u * 64 + t) * 64 + 32 * si + 8 * g + 4 * hh) = w; }
        }
        __syncthreads();
#pragma unroll
        for (int i = 0; i < 4; ++i) { const int p = c.tid + 512 * i, t = (p & 7) + 8 * (p >> 8), vb = (p >> 3) & 31, tc = (((t >> 3) ^ (vb & 7)) << 3) + (t & 7); const bf16x8 vv = vraw[i];
#pragma unroll
            for (int e = 0; e < 8; ++e) VT[(vb * 8 + e) * 72 + tc] = (bf16)vv[e]; }
        __syncthreads();
        if (u + c.G < GLA_UNITS) GLA_A_LOADS(u + c.G);
        { const int dir = c.wave >> 2, mt = c.wave & 3; const bf16* K2T = dir ? K2TB : K2TF; bf16x8 af[4];
#pragma unroll
          for (int s = 0; s < 4; ++s) af[s] = *(const bf16x8*)(K2T + (32 * mt + l32) * 72 + 16 * s + 8 * hh);
          for (int nt = 0; nt < 8; ++nt) { f32x16 acc;
#pragma unroll
              for (int r = 0; r < 16; ++r) acc[r] = 0.f;
#pragma unroll
              for (int s = 0; s < 4; ++s) acc = MFMA32(af[s], *(const bf16x8*)(VT + (32 * nt + l32) * 72 + (((2 * s + hh) ^ (4 * (nt & 1) + (l32 >> 3))) << 3)), acc);
              bf16* dp = DST + (((size_t)u * 2 + dir) * 256 + 32 * nt + l32) * 128 + 32 * mt + 4 * hh;
#pragma unroll
              for (int g = 0; g < 4; ++g) { u32x2 w; w.x = pk2(acc[4 * g], acc[4 * g + 1]); w.y = pk2(acc[4 * g + 2], acc[4 * g + 3]); *(u32x2*)(dp + 8 * g) = w; } } }
        __syncthreads();
    }
#undef GLA_A_LOADS
}
__device__ __forceinline__ void gla_b_phase(ArgP a, const Ctx& c) {
    bf16* DST = (bf16*)(a->ws + WS_DST); const float* AD = (const float*)(a->ws + WS_AD);
    for (int item = c.bx * NTHR + c.tid; item < 32 * 4096; item += c.G * NTHR) {
        const int bhd = item >> 12, rem = item & 4095, v = rem >> 4, k0 = (rem & 15) * 8, bh = bhd >> 1, dir = bhd & 1;
        float S[8];
#pragma unroll
        for (int e = 0; e < 8; ++e) S[e] = 0.f;
#define GLA_B_GROUP(J0, DEPTH) do { u32x4 d[DEPTH]; f32x4 a0[DEPTH], a1[DEPTH]; bf16* p[DEPTH]; \
            _Pragma("unroll") for (int jj = 0; jj < DEPTH; ++jj) { const int j = (J0) + jj, cn = dir ? (j < 4 ? 3 - j : 71 - j) : j; const size_t ud = ((size_t)bh * GLA_NC + cn) * 2 + dir; \
                p[jj] = DST + (ud * 256 + v) * 128 + k0; d[jj] = *(const u32x4*)p[jj]; a0[jj] = *(const f32x4*)(AD + ud * 128 + k0); a1[jj] = *(const f32x4*)(AD + ud * 128 + k0 + 4); } \
            _Pragma("unroll") for (int jj = 0; jj < DEPTH; ++jj) { u32x4 o; o.x = pk2(S[0], S[1]); o.y = pk2(S[2], S[3]); o.z = pk2(S[4], S[5]); o.w = pk2(S[6], S[7]); *(u32x4*)p[jj] = o; \
                const unsigned dw[4] = {d[jj].x, d[jj].y, d[jj].z, d[jj].w}; \
                _Pragma("unroll") for (int e = 0; e < 4; ++e) { S[2 * e] = S[2 * e] * (e < 2 ? a0[jj][2 * e] : a1[jj][2 * e - 4]) + __builtin_bit_cast(float, dw[e] << 16); \
                                              S[2 * e + 1] = S[2 * e + 1] * (e < 2 ? a0[jj][2 * e + 1] : a1[jj][2 * e - 3]) + __builtin_bit_cast(float, dw[e] & 0xffff0000u); } } } while (0)
        for (int j0 = 0; j0 < 64; j0 += 8) GLA_B_GROUP(j0, 8);
        GLA_B_GROUP(64, 4);
#undef GLA_B_GROUP
    }
}
__device__ __forceinline__ void gla_c_phase(ArgP a, const Ctx& c) {
    unsigned char* L = c.lds;
    bf16* QPL = (bf16*)L; bf16* ATTL = (bf16*)(L + 33792); bf16* VT = (bf16*)(L + 43008); float* RED = (float*)(L + 79872);
    const bf16* Z = (const bf16*)(a->ws + WS_BIG); const bf16* QP = (const bf16*)(a->ws + WS_QP); const bf16* ATT = (const bf16*)(a->ws + WS_ATT); const bf16* ST = (const bf16*)(a->ws + WS_DST);
    bf16* MIX = (bf16*)(a->ws + WS_MIX); const float* gn = a->in[I_GNORM];
    const int l32 = c.lane & 31, hh = c.lane >> 5, w = c.wave;
    bf16x8 sfr[8], sbr[8]; bf16x4 rvr[2][4]; f32x4 gcur[4]; u32x4 qst[4], ast; bf16x8 vst[4];
#define GLA_C_UNIT(UU) const int u_ = (UU), bh_ = u_ / GLA_NC, cn_ = u_ % GLA_NC, h_ = bh_ & 3, row0_ = gla_row0(bh_ >> 2, cn_)
#define GLA_C_LOADS_L(UU) do { GLA_C_UNIT(UU); \
        _Pragma("unroll") for (int i = 0; i < 4; ++i) { const int p = c.tid + 512 * i; qst[i] = *(const u32x4*)(QP + ((size_t)u_ * 64 + (p >> 5)) * 256 + (p & 31) * 8); } \
        ast = *(const u32x4*)(ATT + ((size_t)u_ * 64 + (c.tid >> 3)) * 64 + (c.tid & 7) * 8); \
        _Pragma("unroll") for (int i = 0; i < 4; ++i) { const int p = c.tid + 512 * i; vst[i] = *(const bf16x8*)(Z + (size_t)(row0_ + (p & 7) + 8 * (p >> 8)) * ZW + 1024 + h_ * 256 + ((p >> 3) & 31) * 8); } } while (0)
#define GLA_C_LOADS_S(UU) do { const int u_ = (UU); const bf16* SF_ = ST + (((size_t)u_ * 2 + 0) * 256 + 32 * w + l32) * 128 + 8 * hh; const bf16* SB_ = SF_ + (size_t)256 * 128; \
        _Pragma("unroll") for (int s = 0; s < 8; ++s) { sfr[s] = *(const bf16x8*)(SF_ + 16 * s); sbr[s] = *(const bf16x8*)(SB_ + 16 * s); } } while (0)
#define GLA_C_LOADS_E(UU) do { GLA_C_UNIT(UU); \
        _Pragma("unroll") for (int g = 0; g < 4; ++g) gcur[g] = *(const f32x4*)(gn + h_ * 256 + 32 * w + 8 * g + 4 * hh); \
        _Pragma("unroll") for (int nt = 0; nt < 2; ++nt) _Pragma("unroll") for (int g = 0; g < 4; ++g) rvr[nt][g] = *(const bf16x4*)(Z + (size_t)(row0_ + 32 * nt + l32) * ZW + 2048 + h_ * 256 + 32 * w + 8 * g + 4 * hh); } while (0)
    if (c.bx < GLA_UNITS) { GLA_C_LOADS_L(c.bx); GLA_C_LOADS_S(c.bx); GLA_C_LOADS_E(c.bx); }
    for (int u = c.bx; u < GLA_UNITS; u += c.G) {
        const int bh = u / GLA_NC, cn = u % GLA_NC, b = bh >> 2, h = bh & 3, row0 = gla_row0(b, cn); const int un = u + c.G < GLA_UNITS ? u + c.G : u;
#pragma unroll
        for (int i = 0; i < 4; ++i) { const int p = c.tid + 512 * i, t = p >> 5, c8 = (p & 31) * 8; *(u32x4*)(QPL + t * 264 + c8) = qst[i]; }
        { const int t = c.tid >> 3, c8 = (c.tid & 7) * 8; *(u32x4*)(ATTL + t * 72 + c8) = ast; }
#pragma unroll
        for (int i = 0; i < 4; ++i) { const int p = c.tid + 512 * i, t = (p & 7) + 8 * (p >> 8), vb = (p >> 3) & 31, tc = (((t >> 3) ^ (vb & 7)) << 3) + (t & 7); const bf16x8 vv = vst[i];
#pragma unroll
            for (int e = 0; e < 8; ++e) VT[(vb * 8 + e) * 72 + tc] = (bf16)vv[e]; }
        __syncthreads();
        GLA_C_LOADS_L(un);
        f32x16 acc[2];
#pragma unroll
        for (int r = 0; r < 16; ++r) { acc[0][r] = 0.f; acc[1][r] = 0.f; }
#pragma unroll
        for (int s = 0; s < 8; ++s) { const bf16x8 af = sfr[s];
#pragma unroll
            for (int nt = 0; nt < 2; ++nt) acc[nt] = MFMA32(af, *(const bf16x8*)(QPL + (32 * nt + l32) * 264 + 16 * s + 8 * hh), acc[nt]); }
#pragma unroll
        for (int s = 0; s < 8; ++s) { const bf16x8 af = sbr[s];
#pragma unroll
            for (int nt = 0; nt < 2; ++nt) acc[nt] = MFMA32(af, *(const bf16x8*)(QPL + (32 * nt + l32) * 264 + 128 + 16 * s + 8 * hh), acc[nt]); }
#pragma unroll
        for (int s = 0; s < 4; ++s) { const bf16x8 af = *(const bf16x8*)(VT + (32 * w + l32) * 72 + (((2 * s + hh) ^ (4 * (w & 1) + (l32 >> 3))) << 3));
#pragma unroll
            for (int nt = 0; nt < 2; ++nt) acc[nt] = MFMA32(af, *(const bf16x8*)(ATTL + (32 * nt + l32) * 72 + 16 * s + 8 * hh), acc[nt]); }
#pragma unroll
        for (int nt = 0; nt < 2; ++nt) { float ss = 0.f;
#pragma unroll
            for (int r = 0; r < 16; ++r) ss += acc[nt][r] * acc[nt][r];
            ss += __shfl_xor(ss, 32); if (c.lane < 32) RED[w * 64 + 32 * nt + c.lane] = ss; }
        GLA_C_LOADS_S(un);
        __syncthreads();
#pragma unroll
        for (int nt = 0; nt < 2; ++nt) { const int t = 32 * nt + l32; float tot = 0.f;
#pragma unroll
            for (int ww = 0; ww < 8; ++ww) tot += RED[ww * 64 + t];
            const float rstd = 1.f / sqrtf(tot * (1.f / 256.f) + RMS_EPS); const size_t row = (size_t)(row0 + t);
#pragma unroll
            for (int g = 0; g < 4; ++g) { const int v0 = 32 * w + 8 * g + 4 * hh; const bf16x4 rv = rvr[nt][g]; const f32x4 g4 = gcur[g]; float o[4];
#pragma unroll
                for (int e = 0; e < 4; ++e) o[e] = acc[nt][4 * g + e] * rstd * g4[e] * silu_f(bf2f((unsigned short)rv[e]));
                u32x2 wv; wv.x = pk2(o[0], o[1]); wv.y = pk2(o[2], o[3]); *(u32x2*)(MIX + row * D + h * 256 + v0) = wv; } }
        GLA_C_LOADS_E(un);
        __syncthreads();
    }
#undef GLA_C_UNIT
#undef GLA_C_LOADS_L
#undef GLA_C_LOADS_S
#undef GLA_C_LOADS_E
}

constexpr float LOG2E = 1.4426950408889634f;
template <int E0, int E1, bool LOCAL>
__device__ __forceinline__ void na_bias(f32x16& st, const float* tp, int kb) {
    if (LOCAL) { float bv[16];
#pragma unroll
        for (int e = E0; e < E1; ++e) bv[e] = tp[e];
#pragma unroll
        for (int e = E0; e < E1; e += 2) { const f32x2 s2 = (f32x2){st[e], st[e + 1]} + (f32x2){bv[e], bv[e + 1]};
            st[e] = (unsigned)(kb + e) < 16u ? s2.x : -__builtin_inff(); st[e + 1] = (unsigned)(kb + e + 1) < 16u ? s2.y : -__builtin_inff(); } }
}
template <int E0, int E1, bool LOCAL, bool FIXED>
__device__ __forceinline__ void na_tile(f32x16& st, const float* tp, int kb, float& mrun, float& lrun, f32x16& o0, f32x16& o1, bf16x8& pb0, bf16x8& pb1) {
    na_bias<E0, E1, LOCAL>(st, tp, kb);
    if (!FIXED) {
        float mt = st[E0];
#pragma unroll
        for (int e = E0 + 1; e < E1; ++e) mt = fmaxf(mt, st[e]);
        if (__any(mt > mrun + 8.f)) { const float mnew = fmaxf(mrun, fmaxf(mt, __shfl_xor(mt, 32))), sc = __builtin_amdgcn_exp2f(mrun - mnew); mrun = mnew; lrun *= sc;
#pragma unroll
            for (int e = 0; e < 16; ++e) { o0[e] *= sc; o1[e] *= sc; } } }
    float ps = 0.f; float pv[16];
#pragma unroll
    for (int e = 0; e < 16; ++e) { if (e >= E0 && e < E1) { pv[e] = __builtin_amdgcn_exp2f(FIXED ? st[e] : st[e] - mrun); ps += pv[e]; } else pv[e] = 0.f; }
    lrun += ps;
    u32x4 w0, w1;
    w0.x = pk2(pv[0], pv[1]); w0.y = pk2(pv[2], pv[3]); w0.z = pk2(pv[4], pv[5]); w0.w = pk2(pv[6], pv[7]); w1.x = pk2(pv[8], pv[9]); w1.y = pk2(pv[10], pv[11]); w1.z = pk2(pv[12], pv[13]); w1.w = pk2(pv[14], pv[15]);
    pb0 = __builtin_bit_cast(bf16x8, w0); pb1 = __builtin_bit_cast(bf16x8, w1);
}
#define NA_TILEIDX(stp) ((size_t)(b * 32 + h) * 136 + ((stp) < 16 ? 2 * (r0 + ((stp) >> 1)) + ((stp) & 1) : 128 + ((stp) - 16)))
template <bool FIXED>
__device__ __forceinline__ void na_steps(const bf16* KF, const bf16* VF, const bf16x8* qfl, const float* tab, int b, int h, int r, int r0, int lane, int l32, int hh,
                                         f32x16 (&oacc)[2][2], float (&mrun)[2], float (&lrun)[2]) {
    bf16x8 kf[4]; bf16x8 vf[2][2];
    f32x16 nref[2];
#pragma unroll
    for (int qt = 0; qt < 2; ++qt) {
#pragma unroll
        for (int e = 0; e < 16; ++e) nref[qt][e] = FIXED ? -mrun[qt] : 0.f;
        if (FIXED) asm volatile("" : "+v"(nref[qt])); }
    for (int sp = 0; sp < 12; ++sp) {
        const bool local = sp < 8;
#pragma unroll
        for (int half = 0; half < 2; ++half) {
            const int step = 2 * sp + half;
            __builtin_amdgcn_sched_barrier(0);
            { const size_t tile_ = NA_TILEIDX(step);
#pragma unroll
              for (int s = 0; s < 4; ++s) kf[s] = *(const bf16x8*)(KF + (tile_ * 4 + s) * 512 + lane * 8);
#pragma unroll
              for (int dt = 0; dt < 2; ++dt)
#pragma unroll
                  for (int s2 = 0; s2 < 2; ++s2) vf[dt][s2] = *(const bf16x8*)(VF + ((tile_ * 2 + dt) * 2 + s2) * 512 + lane * 8); }
            f32x16 st[2];
            __builtin_amdgcn_s_setprio(1);
#pragma unroll
            for (int qt = 0; qt < 2; ++qt) {
                if (FIXED) st[qt] = nref[qt]; else {
#pragma unroll
                    for (int e = 0; e < 16; ++e) st[qt][e] = 0.f; }
#pragma unroll
                for (int s = 0; s < 4; ++s) st[qt] = MFMA32(kf[s], qfl[(qt * 4 + s) * 64 + lane], st[qt]); }
            __builtin_amdgcn_s_setprio(0);
            bf16x8 pb[2][2];
            if (local) { const int dr31 = (r0 + sp - r + 7) * 31 + 32 * half;
#pragma unroll
                for (int qt = 0; qt < 2; ++qt) { const int qc = 32 * qt + l32; const float* tp = tab + dr31 + (15 - qc + 16 * hh); const int kb = 32 * half + 16 * hh - min(max(qc - 8, 0), 48);
                    if (qt == half) na_tile<0, 16, true, FIXED>(st[qt], tp, kb, mrun[qt], lrun[qt], oacc[0][qt], oacc[1][qt], pb[qt][0], pb[qt][1]);
                    else if (qt == 0) na_tile<0, 8, true, FIXED>(st[qt], tp, kb, mrun[qt], lrun[qt], oacc[0][qt], oacc[1][qt], pb[qt][0], pb[qt][1]);
                    else na_tile<8, 16, true, FIXED>(st[qt], tp, kb, mrun[qt], lrun[qt], oacc[0][qt], oacc[1][qt], pb[qt][0], pb[qt][1]); }
            } else {
#pragma unroll
                for (int qt = 0; qt < 2; ++qt) na_tile<0, 16, false, FIXED>(st[qt], nullptr, 0, mrun[qt], lrun[qt], oacc[0][qt], oacc[1][qt], pb[qt][0], pb[qt][1]); }
            __builtin_amdgcn_s_setprio(1);
#pragma unroll
            for (int dt = 0; dt < 2; ++dt)
#pragma unroll
                for (int s2 = 0; s2 < 2; ++s2) { const bf16x8 va = vf[dt][s2];
#pragma unroll
                    for (int qt = 0; qt < 2; ++qt) oacc[dt][qt] = MFMA32(va, pb[qt][s2], oacc[dt][qt]); }
            __builtin_amdgcn_s_setprio(0);
        }
    }
}
__device__ __forceinline__ void na_phase(ArgP a, const Ctx& c) {
    const bf16* QF = (const bf16*)(a->ws + WS_BIG); const bf16* KF = QF + pg8::NA_KF; const bf16* VF = QF + pg8::NA_VF; bf16* MIX = (bf16*)(a->ws + WS_MIX); const float* rpb = a->in[I_RPB];
    bf16x8* qfl = (bf16x8*)(c.lds + 20480 + c.wave * 8192);
    float* tab = (float*)(c.lds + c.wave * 2560) + 64;
    const int l32 = c.lane & 31, hh = c.lane >> 5;
    const int vb = (c.G % 8 == 0) ? (c.bx % 8) * (c.G / 8) + c.bx / 8 : c.bx;
    int hprev = -1;
    for (int u = vb * NWAVES + c.wave; u < NB * 32 * 64; u += c.NGW) {
        const int r = u & 63, h = (u >> 6) & 31, b = u >> 11, r0 = min(max(r - 4, 0), 56);
        if (h != hprev) { for (int i = c.lane; i < 465; i += 64) tab[i] = rpb[h * 465 + i] * LOG2E; hprev = h; }
#pragma unroll
        for (int qt = 0; qt < 2; ++qt)
#pragma unroll
            for (int s = 0; s < 4; ++s) qfl[(qt * 4 + s) * 64 + c.lane] = *(const bf16x8*)(QF + ((((size_t)(b * 32 + h) * 64 + r) * 2 + qt) * 4 + s) * 512 + c.lane * 8);
        f32x16 oacc[2][2]; float mrun[2], lrun[2] = {0.f, 0.f};
#pragma unroll
        for (int i = 0; i < 2; ++i)
#pragma unroll
            for (int j = 0; j < 2; ++j)
#pragma unroll
                for (int e = 0; e < 16; ++e) oacc[i][j][e] = 0.f;
        { float m0 = -__builtin_inff(), m1 = m0;
#pragma unroll
          for (int half = 0; half < 2; ++half) { const size_t tile_ = NA_TILEIDX(half); bf16x8 kf[4];
#pragma unroll
              for (int s = 0; s < 4; ++s) kf[s] = *(const bf16x8*)(KF + (tile_ * 4 + s) * 512 + c.lane * 8);
              const int dr31 = (r0 - r + 7) * 31 + 32 * half;
#pragma unroll
              for (int qt = 0; qt < 2; ++qt) { f32x16 st;
#pragma unroll
                  for (int e = 0; e < 16; ++e) st[e] = 0.f;
#pragma unroll
                  for (int s = 0; s < 4; ++s) st = MFMA32(kf[s], qfl[(qt * 4 + s) * 64 + c.lane], st);
                  const int qc = 32 * qt + l32; const float* tp = tab + dr31 + (15 - qc + 16 * hh); const int kb = 32 * half + 16 * hh - min(max(qc - 8, 0), 48);
                  na_bias<0, 16, true>(st, tp, kb);
                  float mt = st[0];
#pragma unroll
                  for (int e = 1; e < 16; ++e) mt = fmaxf(mt, st[e]);
                  if (qt == 0) m0 = fmaxf(m0, mt); else m1 = fmaxf(m1, mt); } }
          mrun[0] = fmaxf(m0, __shfl_xor(m0, 32)); mrun[1] = fmaxf(m1, __shfl_xor(m1, 32)); }
        na_steps<true>(KF, VF, qfl, tab, b, h, r, r0, c.lane, l32, hh, oacc, mrun, lrun);
        float lt[2] = {lrun[0] + __shfl_xor(lrun[0], 32), lrun[1] + __shfl_xor(lrun[1], 32)};
        if (__any(!(lt[0] > 1e-30f && lt[0] < 1e30f) || !(lt[1] > 1e-30f && lt[1] < 1e30f))) {
#pragma unroll
            for (int i = 0; i < 2; ++i)
#pragma unroll
                for (int j = 0; j < 2; ++j)
#pragma unroll
                    for (int e = 0; e < 16; ++e) oacc[i][j][e] = 0.f;
            mrun[0] = mrun[1] = -1e30f; lrun[0] = lrun[1] = 0.f;
            na_steps<false>(KF, VF, qfl, tab, b, h, r, r0, c.lane, l32, hh, oacc, mrun, lrun);
            lt[0] = lrun[0] + __shfl_xor(lrun[0], 32); lt[1] = lrun[1] + __shfl_xor(lrun[1], 32); }
#pragma unroll
        for (int qt = 0; qt < 2; ++qt) { const float inv = 1.f / lt[qt]; bf16* op = MIX + (size_t)(b * T + r * 64 + 32 * qt + l32) * D + h * 64 + 4 * hh;
#pragma unroll
            for (int dt = 0; dt < 2; ++dt)
#pragma unroll
                for (int g = 0; g < 4; ++g) { u32x2 w; w.x = pk2(oacc[dt][qt][4 * g] * inv, oacc[dt][qt][4 * g + 1] * inv); w.y = pk2(oacc[dt][qt][4 * g + 2] * inv, oacc[dt][qt][4 * g + 3] * inv);
                    *(u32x2*)(op + 32 * dt + 8 * g) = w; } }
    }
}
#undef NA_TILEIDX

__device__ __forceinline__ void final_norm_phase(ArgP a, const Ctx& c) {
    const float* XR = (const float*)(a->ws + WS_XR); const float* g = a->in[I_NOUT];
    f32x4 gv[8];
#pragma unroll
    for (int j = 0; j < 8; ++j) gv[j] = *(const f32x4*)(g + 4 * c.lane + 256 * j);
    for (int row = c.gw; row < ML; row += 2 * c.NGW) {
        const float* x0 = XR + (size_t)row * D; const float* x1 = XR + (size_t)(row + c.NGW) * D; f32x4 v0[8], v1[8]; float s0 = 0.f, s1 = 0.f;
#pragma unroll
        for (int j = 0; j < 8; ++j) { v0[j] = *(const f32x4*)(x0 + 4 * c.lane + 256 * j); v1[j] = *(const f32x4*)(x1 + 4 * c.lane + 256 * j); }
#pragma unroll
        for (int j = 0; j < 8; ++j) { s0 += (v0[j].x * v0[j].x + v0[j].y * v0[j].y) + (v0[j].z * v0[j].z + v0[j].w * v0[j].w); s1 += (v1[j].x * v1[j].x + v1[j].y * v1[j].y) + (v1[j].z * v1[j].z + v1[j].w * v1[j].w); }
        const float r0 = 1.f / sqrtf(wave_sum(s0) * (1.f / D) + RMS_EPS), r1 = 1.f / sqrtf(wave_sum(s1) * (1.f / D) + RMS_EPS);
#pragma unroll
        for (int j = 0; j < 8; ++j) { *(f32x4*)(a->out + (size_t)row * D + 4 * c.lane + 256 * j) = v0[j] * r0 * gv[j]; *(f32x4*)(a->out + (size_t)(row + c.NGW) * D + 4 * c.lane + 256 * j) = v1[j] * r1 * gv[j]; } }
}

enum Phase { PH_PROLOGUE = 0, PH_L0_N1, PH_L0_GU1, PH_L0_D1, PH_L0_NM, PH_L0_WIN, PH_L0_FN1, PH_L0_FN2, PH_L0_GA, PH_L0_GB, PH_L0_GC, PH_L0_WOUT, PH_L0_N2, PH_L0_GU2, PH_L0_D2,
             PH_L1_N1, PH_L1_GU1, PH_L1_D1, PH_L1_NM, PH_L1_QKV, PH_L1_NA, PH_L1_WOUT, PH_L1_N2, PH_L1_GU2, PH_L1_D2, PH_FINAL, NPHASES };

__global__ void __launch_bounds__(NTHR, 2) mega(Args args) {
    extern __shared__ __attribute__((aligned(16))) unsigned char lds[];
    Ctx c; c.lds = lds; c.tid = threadIdx.x; c.lane = c.tid & 63; c.wave = __builtin_amdgcn_readfirstlane(c.tid >> 6); c.bx = blockIdx.x; c.G = gridDim.x; c.gw = c.bx * NWAVES + c.wave; c.NGW = c.G * NWAVES;
    LAS unsigned char* ldsl = (LAS unsigned char*)lds;
    volatile LAS unsigned* MISC = (volatile LAS unsigned*)(ldsl + MISC_OFF);
    for (int u = c.tid; u < (LDS_BYTES - RING_BYTES) / 4; u += NTHR) ((LAS unsigned*)(ldsl + RING_BYTES))[u] = 0u;
    __syncthreads();
#define KA() ({ ArgP p_ = (ArgP)__builtin_amdgcn_kernarg_segment_ptr(); asm volatile("" : "+s"(p_)); p_; })
    unsigned char* ws = KA()->ws;
    unsigned* ctl = (unsigned*)(ws + WS_CTL);
    XcdBarrier bar; bar.bar = ctl + CW_BAR + KA()->li * XCD_BAR_WORDS; bar.x = 0; bar.st = nullptr;
    const int lo = KA()->ph_lo, hi = KA()->ph_hi;
    if (hi - lo > 1) bar = xcd_barrier_post(ctl + CW_BAR + KA()->li * XCD_BAR_WORDS, MISC + 8);
#ifndef ONLY_PH
#define ONLY_PH -1
#endif
#define IN(k) ((ONLY_PH < 0 || ONLY_PH == (k)) && lo <= (k) && (k) < hi)
    float* MODS = (float*)(ws + WS_MODS); float* XR = (float*)(ws + WS_XR); bf16* U = (bf16*)(ws + WS_U); bf16* MIX = (bf16*)(ws + WS_MIX); bf16* BIG = (bf16*)(ws + WS_BIG);

#define PH_BEGIN(k) { if (IN(k)) {
#define PH_END(k) } if (IN(k) && IN((k) + 1)) xcd_barrier(bar); }
    const int rep = KA()->rep;
    float* XRC = XR + (size_t)ML * D; float* SLAB = (float*)(ws + WS_SLAB);
    PH_BEGIN(PH_PROLOGUE) if (rep == 0) ada_units(KA(), c); tables(KA(), c); convert_layer(KA(), c, 0); PH_END(PH_PROLOGUE)

#define FFN_HALF(PN, PGU, PD, LAYER, JSUB, NORMIDX, WGU, WD, LATSRC, CTXSRC, WITHCTX) \
    PH_BEGIN(PN) norm_mod_phase(c, LATSRC, CTXSRC, KA()->in[(LAYER ? I_L1 : I_L0) + NORMIDX], MODS + (size_t)LAYER * 5 * NMODW, JSUB, U, WITHCTX, PN == PH_L0_N1 ? XRC : nullptr, (PN == PH_L0_N1 || !(WITHCTX) || rep) ? nullptr : SLAB); \
                  if (PN == PH_L1_N1) convert_layer(KA(), c, 1); PH_END(PN) \
    PH_BEGIN(PGU) pg8::PlainSched S; S.init(U, D, (WITHCTX) ? MT / 256 : ML / 256, ws + WGU, D, 2 * FF / 256, D, c.G, c.bx); pg8::EpiSwiGLU E{BIG}; \
                   pg8::gemm_phase<pg8::EpiSwiGLU, pg8::PlainSched, true>(ldsl, pg8::Gemm{64, 64, D, 0, 32768, 32768}, S, E); PH_END(PGU) \
    PH_BEGIN(PD) ResidSched S; S.init(BIG, FF, ws + WD, FF, FF, WITHCTX, c.G, c.bx, 32768); \
                  pg8::EpiResid E{rep ? XR : LATSRC, rep ? XRC : CTXSRC, XR, MODS + (size_t)LAYER * 5 * NMODW + (3 * JSUB + 2) * D, SLAB, rep ? 0.f : 0.5f}; \
                  pg8::gemm_phase<pg8::EpiResid, ResidSched, true>(ldsl, pg8::Gemm{64, 64, FF, 0, 32768, 32768}, S, E); PH_END(PD)

    FFN_HALF(PH_L0_N1, PH_L0_GU1, PH_L0_D1, 0, 0, 2, W_GU1, W_D1, KA()->in[I_X], KA()->in[I_CTX], true)
    PH_BEGIN(PH_L0_NM) norm_mod_phase(c, XR, XRC, KA()->in[I_L0 + 3], MODS, 1, U, true, nullptr, rep ? nullptr : SLAB); PH_END(PH_L0_NM)
    PH_BEGIN(PH_L0_WIN) StoreSched S; S.p.init(U, D, MT / 256, ws + W_MIXA, D, ZW / 256, D, c.G, c.bx); S.ldc = ZW; S.nscale = 0; S.sc0 = 1.f; pg8::EpiStore E{BIG};
        pg8::gemm_phase<pg8::EpiStore, StoreSched, true>(ldsl, pg8::Gemm{64, 64, D, 0, 32768, 32768}, S, E); PH_END(PH_L0_WIN)
    PH_BEGIN(PH_L0_FN1) Fn1Sched S{c.G, c.bx, (const char*)(ws + WS_DFTC), (const char*)BIG}; pg8::EpiStore E{(bf16*)(ws + WS_F1T)};
        pg8::gemm_phase<pg8::EpiStore, Fn1Sched, true>(ldsl, pg8::Gemm{256, ZW, 256, 1, 128, 128}, S, E);
        { Fn1cSched Sc{c.G, (c.bx + 64) % c.G, (const char*)(ws + WS_DFTC), (const char*)BIG}; pg8::gemm_phase<pg8::EpiStore, Fn1cSched, true>(ldsl, pg8::Gemm{256, ZW, 256, 0, 128, 128}, Sc, E); }
        gla_a_phase(KA(), c); PH_END(PH_L0_FN1)
    PH_BEGIN(PH_L0_FN2) { FabSched S{c.G, c.bx, (const char*)(ws + WS_WA), (const char*)(ws + WS_F1T)}; pg8::EpiFnA E{(bf16*)(ws + WS_YP), (const float*)(ws + WS_TW)};
          pg8::gemm_phase<pg8::EpiFnA, FabSched, true>(ldsl, pg8::Gemm{128, 128, 128, 0, 128, 128}, S, E); }
        gla_b_phase(KA(), c); PH_END(PH_L0_FN2)
    PH_BEGIN(PH_L0_GC) { FabSched S{c.G, c.bx, (const char*)(ws + WS_WB), (const char*)(ws + WS_YP)}; pg8::EpiFnB E{MIX};
          pg8::gemm_phase<pg8::EpiFnB, FabSched, true>(ldsl, pg8::Gemm{128, 128, 128, 0, 128, 128}, S, E); }
        { Fn2cSched S{c.G, (c.bx + 192) % c.G, (const char*)(ws + WS_DFT256), (const char*)(ws + WS_F1TC)}; pg8::EpiStore E{MIX};
          pg8::gemm_phase<pg8::EpiStore, Fn2cSched, true>(ldsl, pg8::Gemm{512, 512, 512, 0, 128, 128}, S, E); }
        gla_c_phase(KA(), c); PH_END(PH_L0_GC)
    PH_BEGIN(PH_L0_WOUT) ResidSched S; S.init(MIX, D, ws + W_OUT, D, D, true, c.G, c.bx); pg8::EpiResid E{XR, XRC, XR, MODS + 5 * D, SLAB, rep ? 0.f : 1.f};
        pg8::gemm_phase<pg8::EpiResid, ResidSched, true>(ldsl, pg8::Gemm{D, 64, D, 0, 128, 32768}, S, E); PH_END(PH_L0_WOUT)
    FFN_HALF(PH_L0_N2, PH_L0_GU2, PH_L0_D2, 0, 2, 4, W_GU2, W_D2, XR, XRC, true)

    FFN_HALF(PH_L1_N1, PH_L1_GU1, PH_L1_D1, 1, 0, 2, W_GU1, W_D1, XR, XRC, true)
    PH_BEGIN(PH_L1_NM) norm_mod_phase(c, XR, XRC, KA()->in[I_L1 + 3], MODS + (size_t)5 * NMODW, 1, U, true, nullptr, rep ? nullptr : SLAB); PH_END(PH_L1_NM)
    PH_BEGIN(PH_L1_QKV) QkvSched S{c.G, c.bx, (const char*)U, (const char*)(ws + W_MIXA)}; pg8::EpiQkvFrag E{BIG};
        pg8::gemm_phase<pg8::EpiQkvFrag, QkvSched, true>(ldsl, pg8::Gemm{64, 64, D, 0, 32768, 32768}, S, E); PH_END(PH_L1_QKV)
    PH_BEGIN(PH_L1_NA) na_phase(KA(), c); PH_END(PH_L1_NA)
    PH_BEGIN(PH_L1_WOUT) ResidSched S; S.init(MIX, D, ws + W_OUT, D, D, false, c.G, c.bx); pg8::EpiResid E{XR, XRC, XR, MODS + (size_t)5 * NMODW + 5 * D, SLAB, rep ? 0.f : 1.f};
        pg8::gemm_phase<pg8::EpiResid, ResidSched, true>(ldsl, pg8::Gemm{D, 64, D, 0, 128, 32768}, S, E); PH_END(PH_L1_WOUT)
    FFN_HALF(PH_L1_N2, PH_L1_GU2, PH_L1_D2, 1, 2, 4, W_GU2, W_D2, XR, XRC, false)
    PH_BEGIN(PH_FINAL) final_norm_phase(KA(), c); PH_END(PH_FINAL)
#undef IN
#undef FFN_HALF
}

extern "C" void kernel_launch(void* const* d_in, const int* in_sizes, int n_in, void* d_out, int out_size, void* d_ws, size_t ws_size, hipStream_t stream) {
    static int grid = 0;
    if (grid == 0) {
        if (n_in != 33 || in_sizes[0] != ML * D || out_size != ML * D || ws_size < WS_END) { fprintf(stderr, "kernel_launch: unexpected problem (n_in %d, in0 %d, out %d, ws %zu < %zu)\n", n_in, n_in > 0 ? in_sizes[0] : -1, out_size, ws_size, (size_t)WS_END); grid = -1; return; }
        int dev = 0, cus = 0, per_cu = 0;
        if (hipGetDevice(&dev) != hipSuccess || hipDeviceGetAttribute(&cus, hipDeviceAttributeMultiprocessorCount, dev) != hipSuccess) { grid = -1; return; }
        if (hipFuncSetAttribute((const void*)mega, hipFuncAttributeMaxDynamicSharedMemorySize, LDS_BYTES) != hipSuccess) { fprintf(stderr, "kernel_launch: hipFuncSetAttribute failed\n"); grid = -1; return; }
        if (hipOccupancyMaxActiveBlocksPerMultiprocessor(&per_cu, (const void*)mega, NTHR, LDS_BYTES) != hipSuccess || per_cu < 1) fprintf(stderr, "kernel_launch: occupancy query says %d\n", per_cu);
        (void)hipGetLastError();
        grid = cus;
    }
    if (grid < 0) return;
    (void)hipMemsetAsync((char*)d_ws + WS_CTL, 0, CTL_ZERO_BYTES, stream);
    Args a{};
    for (int i = 0; i < 33; ++i) a.in[i] = (const float*)d_in[i];
    a.out = (float*)d_out; a.ws = (unsigned char*)d_ws;
#if MK_FUSED
#ifdef PROBE_PHASES
    { const int rp[] = {PROBE_PHASES}; const int nrp = (int)(sizeof(rp) / sizeof(rp[0])); int lo = 0, li = 0;
      for (int i = 0; i <= nrp; ++i) { const int hi = i < nrp ? rp[i] + 1 : NPHASES;
          if (hi > lo) { a.ph_lo = lo; a.ph_hi = hi; a.rep = 0; a.li = li++; hipLaunchKernelGGL(mega, dim3(grid), dim3(NTHR), LDS_BYTES, stream, a); }
          if (i < nrp) { a.ph_lo = rp[i]; a.ph_hi = rp[i] + 1; a.rep = 1; a.li = li++; hipLaunchKernelGGL(mega, dim3(grid), dim3(NTHR), LDS_BYTES, stream, a); }
          lo = hi; } }
#else
    a.ph_lo = 0; a.ph_hi = NPHASES; hipLaunchKernelGGL(mega, dim3(grid), dim3(NTHR), LDS_BYTES, stream, a);
#endif
#else
    for (int ph = 0; ph < NPHASES; ++ph) { a.ph_lo = ph; a.ph_hi = ph + 1; hipLaunchKernelGGL(mega, dim3(grid), dim3(NTHR), LDS_BYTES, stream, a); }
#endif
}
```

```cpp
#include <hip/hip_runtime.h>
#include <cstdio>
#include <cstdint>

#ifndef MK_FUSED
#define MK_FUSED 1
#endif

#define GAS __attribute__((address_space(1)))
#define LAS __attribute__((address_space(3)))
typedef unsigned short bf16;
typedef short bf16x8 __attribute__((ext_vector_type(8)));
typedef short bf16x4 __attribute__((ext_vector_type(4)));
typedef float f32x4 __attribute__((ext_vector_type(4)));
typedef float f32x2 __attribute__((ext_vector_type(2)));
typedef unsigned u32x4 __attribute__((ext_vector_type(4)));
typedef unsigned u32x2 __attribute__((ext_vector_type(2)));

constexpr int D = 2048, NB = 4, T = 4096, TC = 256, ML = NB * T, MC = NB * TC, MT = ML + MC, FF = 5632, NMODW = 9 * D;
constexpr int ZW = 4352;
constexpr int QW = 6144;
constexpr float RMS_EPS = 1e-6f;

constexpr size_t MiB = 1u << 20;
constexpr size_t WS_CTL = 0, WS_MODS = 1 * MiB, CTL_ZERO_BYTES = 2 * MiB;
constexpr size_t WS_DFTC = 2 * MiB, WS_DFT256 = 2 * MiB + 256 * 1024, WS_ROPE = 2 * MiB + 512 * 1024;
constexpr size_t WS_WA = 2 * MiB + 768 * 1024, WS_WB = WS_WA + 64 * 1024, WS_TW = 3 * MiB;
constexpr size_t WS_YP = 4 * MiB;
constexpr size_t WS_W = 68 * MiB;
constexpr size_t W_GU1 = WS_W, W_GU2 = WS_W + 44 * MiB, W_D1 = WS_W + 88 * MiB, W_D2 = WS_W + 110 * MiB, W_MIXA = WS_W + 132 * MiB, W_OUT = WS_W + 156 * MiB;
constexpr size_t WS_XR = 232 * MiB;
constexpr size_t WS_U = 368 * MiB;
constexpr size_t WS_MIX = 436 * MiB;
constexpr size_t WS_BIG = 504 * MiB;
constexpr size_t WS_F1T = 708 * MiB;
constexpr size_t WS_F1TC = 772 * MiB;
constexpr size_t WS_DST = 776 * MiB;
constexpr size_t WS_QP = 912 * MiB;
constexpr size_t WS_ATT = 946 * MiB;
constexpr size_t WS_AD = 955 * MiB;
constexpr size_t WS_SLAB = 957 * MiB;
constexpr size_t WS_END = 989 * MiB;
constexpr int CW_BAR = 4096;

__device__ __forceinline__ float bf2f(unsigned short h) { return __builtin_bit_cast(float, (unsigned)h << 16); }
typedef __bf16 bf16x2_t __attribute__((ext_vector_type(2)));
__device__ __forceinline__ unsigned pk2(float lo, float hi) { const f32x2 v = {lo, hi}; return __builtin_bit_cast(unsigned, __builtin_convertvector(v, bf16x2_t)); }
__device__ __forceinline__ unsigned f2bf(float f) { return pk2(f, 0.f) & 0xffffu; }
__device__ __forceinline__ float wave_sum(float v) {
#pragma unroll
    for (int o = 1; o < 64; o <<= 1) v += __shfl_xor(v, o);
    return v;
}
__device__ __forceinline__ float wave_max(float v) {
#pragma unroll
    for (int o = 1; o < 64; o <<= 1) v = fmaxf(v, __shfl_xor(v, o));
    return v;
}
__device__ __forceinline__ float rdl(float v, int l) { return __builtin_bit_cast(float, __builtin_amdgcn_readlane(__builtin_bit_cast(int, v), l)); }
__device__ __forceinline__ int rdli(int v, int l) { return __builtin_amdgcn_readlane(v, l); }
__device__ __forceinline__ float silu_f(float x) { return x / (1.f + __expf(-x)); }

namespace pg8 {
#define PG8_LAS __attribute__((address_space(3)))
constexpr int BM = 256, BK = 64, HALF = 128, HTB = HALF * BK * 2, STAGE_BYTES = 8 * HTB, NXCD = 8, WGM = 4;
__host__ __device__ __forceinline__ int lds_byte(int r, int c) { const int st = (r >> 4) * 2 + (c >> 5), rr = r & 15, cc = c & 31, ob = rr * 64 + cc * 2; return st * 1024 + (ob ^ (((ob >> 9) & 1) << 5)); }
__host__ __device__ __forceinline__ void stage_rc(int b, int& R, int& C) { const int st = b / 1024, sb = b % 1024, swz = sb ^ (((sb >> 9) & 1) << 5); R = (st >> 1) * 16 + swz / 64; C = (st & 1) * 32 + (swz % 64) / 2; }
__host__ __device__ __forceinline__ int perm32(int rho) { const int n = rho >> 4, i = rho & 15; return 8 * (i >> 2) + 4 * n + (i & 3); }

struct Unit { int pm, pn; const char* a; const char* b; long ooff; int ldc; float sc; int nt, flags; };
struct Gemm { int lda, ldb, K, bmap, ksA, ksB; };

struct TileOrder {
    int nM, nN, nwg;
    __device__ __forceinline__ void init(int nM_, int nN_) { nM = nM_; nN = nN_; nwg = nM_ * nN_; }
    __device__ __forceinline__ void decode(int L, int& pm, int& pn) const {
        int wgid = L; { const int q = nwg / NXCD, r = nwg % NXCD, xcd = wgid % NXCD, off = wgid / NXCD; wgid = (xcd < r ? xcd * (q + 1) : r * (q + 1) + (xcd - r) * q) + off; }
        const int nig = WGM * nN, gid = wgid / nig, fm = gid * WGM, gsz = (nM - fm) < WGM ? (nM - fm) : WGM;
        pm = fm + ((wgid % nig) % gsz); pn = (wgid % nig) / gsz;
    }
};
struct PlainSched {
    TileOrder to; int G, c, ntk; const char* A; const char* Bt; size_t a_t, b_t;
    __device__ __forceinline__ void init(const void* A_, int lda, int nM, const void* Bt_, int ldb, int nN, int K, int G_, int c_) { to.init(nM, nN); G = G_; c = c_; ntk = K / BK; A = (const char*)A_; Bt = (const char*)Bt_; a_t = (size_t)BM * lda * 2; b_t = (size_t)BM * ldb * 2; }
    __device__ __forceinline__ bool next(int i, Unit& u) const {
        const long L = (long)i * G + c; if (L >= to.nwg) return false;
        to.decode((int)L, u.pm, u.pn); u.a = A + (size_t)u.pm * a_t; u.b = Bt + (size_t)u.pn * b_t; u.ooff = 0; u.ldc = 0; u.sc = 1.f; u.nt = ntk; u.flags = 0; return true;
    }
};

__device__ __forceinline__ unsigned cvt_pk_bf16(float lo, float hi) { unsigned r; asm volatile("v_cvt_pk_bf16_f32 %0, %1, %2" : "=v"(r) : "v"(lo), "v"(hi)); return r; }

struct EpiStore {
    static constexpr bool PERM = true;
    bf16* O;
    __device__ __forceinline__ void operator()(const f32x4 (&acc)[2][2][4][2], const Unit& u, int wr, int wc, int fr, int fq) const {
        const bool pc = (u.flags & 8) != 0;
        bf16* base = O + u.ooff + (size_t)(wr * 64 + fr) * u.ldc + (pc ? (wc >> 1) * 128 + (wc & 1) * 32 : wc * 32) + 8 * fq; const float sc = u.sc;
#pragma unroll
        for (int ai = 0; ai < 2; ++ai)
#pragma unroll
            for (int m = 0; m < 4; ++m) { bf16* rowp = base + (size_t)(ai * HALF + m * 16) * u.ldc;
#pragma unroll
                for (int bj = 0; bj < 2; ++bj) { const f32x4 v0 = acc[ai][bj][m][0] * sc, v1 = acc[ai][bj][m][1] * sc;
                    u32x4 w; w.x = cvt_pk_bf16(v0[0], v0[1]); w.y = cvt_pk_bf16(v0[2], v0[3]); w.z = cvt_pk_bf16(v1[0], v1[1]); w.w = cvt_pk_bf16(v1[2], v1[3]);
                    *(u32x4*)(rowp + bj * (pc ? 256 : HALF)) = w; } }
    }
};
struct EpiFnA {
    static constexpr bool PERM = true;
    bf16* Y; const float* TW;
    __device__ __forceinline__ void operator()(const f32x4 (&acc)[2][2][4][2], const Unit& u, int wr, int wc, int fr, int fq) const {
        if (wr != 0) return;
        const int t2 = (wc * 32 + 8 * fq) & 63;
        f32x4 cs[4][4];
#pragma unroll
        for (int m = 0; m < 4; ++m)
#pragma unroll
            for (int h = 0; h < 4; ++h) cs[m][h] = *(const f32x4*)(TW + ((16 * m + fr) * 64 + t2) * 2 + 4 * h);
#pragma unroll
        for (int bj = 0; bj < 2; ++bj) { const int rho = u.pn * BM + bj * HALF + wc * 32 + 8 * fq, nb = rho >> 6, b = nb >> 10, n = nb & 1023;
#pragma unroll
            for (int m = 0; m < 4; ++m) { const int t1p = 16 * m + fr; float yp[8], yq[8];
#pragma unroll
                for (int h = 0; h < 4; ++h) { const f32x4 c4 = cs[m][h];
                    const float p0 = acc[0][bj][m][h >> 1][2 * (h & 1)], q0 = acc[1][bj][m][h >> 1][2 * (h & 1)], p1 = acc[0][bj][m][h >> 1][2 * (h & 1) + 1], q1 = acc[1][bj][m][h >> 1][2 * (h & 1) + 1];
                    yp[2 * h] = c4.x * p0 - c4.y * q0; yq[2 * h] = c4.y * p0 + c4.x * q0; yp[2 * h + 1] = c4.z * p1 - c4.w * q1; yq[2 * h + 1] = c4.w * p1 + c4.z * q1; }
                bf16* o = Y + (((size_t)(b * 64 + t1p) * 1024 + n) * 128 + t2);
                u32x4 w; w.x = cvt_pk_bf16(yp[0], yp[1]); w.y = cvt_pk_bf16(yp[2], yp[3]); w.z = cvt_pk_bf16(yp[4], yp[5]); w.w = cvt_pk_bf16(yp[6], yp[7]); *(u32x4*)o = w;
                w.x = cvt_pk_bf16(yq[0], yq[1]); w.y = cvt_pk_bf16(yq[2], yq[3]); w.z = cvt_pk_bf16(yq[4], yq[5]); w.w = cvt_pk_bf16(yq[6], yq[7]); *(u32x4*)(o + 64) = w; } }
    }
};
struct EpiFnB {
    static constexpr bool PERM = true;
    bf16* M;
    __device__ __forceinline__ void operator()(const f32x4 (&acc)[2][2][4][2], const Unit& u, int wr, int wc, int fr, int fq) const {
        if (wr != 0) return;
#pragma unroll
        for (int bj = 0; bj < 2; ++bj) { const int sg = u.pn * BM + bj * HALF + wc * 32 + 8 * fq, n = sg & 1023, t1p = (sg >> 10) & 63, b = sg >> 16;
#pragma unroll
            for (int m = 0; m < 4; ++m) { const int t2p = 16 * m + fr; const f32x4 v0 = acc[0][bj][m][0], v1 = acc[0][bj][m][1];
                u32x4 w; w.x = cvt_pk_bf16(v0[0], v0[1]); w.y = cvt_pk_bf16(v0[2], v0[3]); w.z = cvt_pk_bf16(v1[0], v1[1]); w.w = cvt_pk_bf16(v1[2], v1[3]);
                *(u32x4*)(M + (size_t)(b * T + t1p + 64 * t2p) * D + 1024 + n) = w; } }
    }
};
constexpr size_t NA_KF = (size_t)NB * 32 * 64 * 2 * 4 * 512, NA_VF = NA_KF + (size_t)NB * 32 * 136 * 4 * 512;
struct EpiQkvFrag {
    static constexpr bool PERM = true;
    bf16* O;
    __device__ __forceinline__ void operator()(const f32x4 (&acc)[2][2][4][2], const Unit& u, int wr, int wc, int fr, int fq) const {
        const float sc = u.sc;
#pragma unroll
        for (int ai = 0; ai < 2; ++ai)
#pragma unroll
            for (int m = 0; m < 4; ++m) { const int row = u.pm * BM + ai * HALF + wr * 64 + m * 16 + fr;
#pragma unroll
                for (int bj = 0; bj < 2; ++bj) { const int col = u.pn * BM + bj * HALF + wc * 32 + 8 * fq;
                    const f32x4 v0 = acc[ai][bj][m][0] * sc, v1 = acc[ai][bj][m][1] * sc;
                    u32x4 w; w.x = cvt_pk_bf16(v0[0], v0[1]); w.y = cvt_pk_bf16(v0[2], v0[3]); w.z = cvt_pk_bf16(v1[0], v1[1]); w.w = cvt_pk_bf16(v1[2], v1[3]);
                    const int tr = (u.flags & 2) ? col : row;
                    int b, tile, tau; if (tr < ML) { b = tr >> 12; tile = (tr & 4095) >> 5; tau = tr & 31; } else { const int j = tr - ML; b = j >> 8; tile = 128 + ((j & 255) >> 5); tau = j & 31; }
                    if (u.flags & 2) { const int h = row >> 6, d = row & 63;
                        *(u32x4*)(O + NA_VF + ((((size_t)(b * 32 + h) * 136 + tile) * 2 + (d >> 5)) * 2 + ((tau >> 3) & 1)) * 512 + (((tau >> 4) & 1) * 32 + (d & 31)) * 8) = w; }
                    else { const int cc = col & 2047, h = cc >> 6, c8 = (cc & 63) >> 3;
                        if (col >= 2048) { const int l32 = (((tau >> 3) & 1) << 4) | (((tau >> 2) & 1) << 3) | (((tau >> 4) & 1) << 2) | (tau & 3);
                            *(u32x4*)(O + NA_KF + (((size_t)(b * 32 + h) * 136 + tile) * 4 + (c8 >> 1)) * 512 + ((c8 & 1) * 32 + l32) * 8) = w; }
                        else if (tr < ML) { const int t = tr & 4095;
                            *(u32x4*)(O + ((((size_t)(b * 32 + h) * 64 + (t >> 6)) * 2 + ((t >> 5) & 1)) * 4 + (c8 >> 1)) * 512 + ((c8 & 1) * 32 + (t & 31)) * 8) = w; } } } }
    }
};
struct EpiSwiGLU {
    static constexpr bool PERM = true;
    bf16* H;
    __device__ __forceinline__ void operator()(const f32x4 (&acc)[2][2][4][2], const Unit& u, int wr, int wc, int fr, int fq) const {
        bf16* base = H + (((size_t)u.pm * (FF / 64) + 2 * u.pn + (wc >> 1)) * BM + wr * 64 + fr) * 64 + (wc & 1) * 32 + 8 * fq;
#pragma unroll
        for (int ai = 0; ai < 2; ++ai)
#pragma unroll
            for (int m = 0; m < 4; ++m) { float h[8];
#pragma unroll
                for (int n = 0; n < 2; ++n)
#pragma unroll
                    for (int e = 0; e < 4; ++e) { const float a = acc[ai][0][m][n][e], g = acc[ai][1][m][n][e];
                        h[4 * n + e] = a * __builtin_amdgcn_rcpf(1.f + __builtin_amdgcn_exp2f(-1.4426950408889634f * a)) * g; }
                u32x4 w; w.x = cvt_pk_bf16(h[0], h[1]); w.y = cvt_pk_bf16(h[2], h[3]); w.z = cvt_pk_bf16(h[4], h[5]); w.w = cvt_pk_bf16(h[6], h[7]);
                *(u32x4*)(base + (size_t)(ai * HALF + m * 16) * 64) = w; }
    }
};
struct EpiResid {
    static constexpr bool PERM = false;
    const float* base_lat; const float* base_ctx; float* out; const float* gate; float* slab; float gs;
    __device__ __forceinline__ void operator()(const f32x4 (&acc)[2][2][4][2], const Unit& u, int wr, int wc, int fr, int fq) const {
        const int modid = u.pm < ML / BM ? u.pm / (T / BM) : NB; const float* gp = gate + (size_t)modid * NMODW;
        const int col0 = u.pn * BM + wc * 32 + 4 * fq;
        f32x4 gv[2][2];
#pragma unroll
        for (int bj = 0; bj < 2; ++bj)
#pragma unroll
            for (int n = 0; n < 2; ++n) gv[bj][n] = *(const f32x4*)(gp + col0 + bj * HALF + n * 16) * gs;
        if (u.flags & 1) {
            if (gs != 0.f) { float* sp = slab + ((size_t)(u.flags >> 1) * MC + (size_t)(u.pm - ML / BM) * BM) * D;
#pragma unroll
                for (int ai = 0; ai < 2; ++ai)
#pragma unroll
                    for (int m = 0; m < 4; ++m) { const size_t off = (size_t)(ai * HALF + wr * 64 + m * 16 + fr) * D + col0;
#pragma unroll
                        for (int bj = 0; bj < 2; ++bj)
#pragma unroll
                            for (int n = 0; n < 2; ++n) *(f32x4*)(sp + off + bj * HALF + n * 16) = gv[bj][n] * acc[ai][bj][m][n]; } }
            return; }
        const float* bp = u.pm < ML / BM ? base_lat + (size_t)u.pm * BM * D : base_ctx + (size_t)(u.pm - ML / BM) * BM * D;
        float* op = out + (size_t)u.pm * BM * D;
#pragma unroll
        for (int am = 0; am < 4; ++am) { const int ai = am >> 1, m0 = (am & 1) * 2; f32x4 bv[2][2][2];
#pragma unroll
            for (int mm = 0; mm < 2; ++mm) { const size_t off = (size_t)(ai * HALF + wr * 64 + (m0 + mm) * 16 + fr) * D + col0;
#pragma unroll
                for (int bj = 0; bj < 2; ++bj)
#pragma unroll
                    for (int n = 0; n < 2; ++n) bv[mm][bj][n] = *(const f32x4*)(bp + off + bj * HALF + n * 16); }
#pragma unroll
            for (int mm = 0; mm < 2; ++mm) { const size_t off = (size_t)(ai * HALF + wr * 64 + (m0 + mm) * 16 + fr) * D + col0;
#pragma unroll
                for (int bj = 0; bj < 2; ++bj)
#pragma unroll
                    for (int n = 0; n < 2; ++n) *(f32x4*)(op + off + bj * HALF + n * 16) = bv[mm][bj][n] + gv[bj][n] * acc[ai][bj][m0 + mm][n]; } }
    }
};

template <class Epi, class Sched, bool ALIGN_EPI>
__device__ __forceinline__ void gemm_phase(PG8_LAS unsigned char* lds, const Gemm g, const Sched& S, const Epi& E) {
    const int tid = threadIdx.x, wid = __builtin_amdgcn_readfirstlane(tid >> 6), lane = tid & 63, wr = wid >> 2, wc = wid & 3, fr = lane & 15, fq = lane >> 4;
    unsigned voffA[2], voffB[2];
#pragma unroll
    for (int i = 0; i < 2; ++i) { int R, C; stage_rc(tid * 16 + i * 8192, R, C); const int Rb = Epi::PERM ? ((R & ~31) + perm32(R & 31)) : R;
        voffA[i] = (unsigned)(R * g.lda + C) * 2u; voffB[i] = (unsigned)((g.bmap ? 64 * (Rb & 63) + (Rb >> 6) : Rb) * g.ldb + C) * 2u; }
    const size_t kstepA = (size_t)g.ksA, kstepB = (size_t)g.ksB;
    const size_t hstepA = (size_t)HALF * g.lda * 2, hstepB = (size_t)(g.bmap ? 2 : HALF) * g.ldb * 2;
    const unsigned ldsw = (unsigned)wid * 1024u;
    const int aoff = lds_byte(wr * 64 + fr, fq * 8), boff = lds_byte(wc * 32 + fr, fq * 8);
#define PG8_SA(b, h) (((b) * 2 + (h)) * HTB)
#define PG8_SB(b, h) ((4 + (b) * 2 + (h)) * HTB)
#define PG8_STAGE(bufoff, gbase, voff) do { _Pragma("unroll") for (int _i = 0; _i < 2; ++_i) \
        __builtin_amdgcn_global_load_lds((const unsigned*)((const char*)(gbase) + (voff)[_i]), (PG8_LAS unsigned*)(lds + (bufoff) + ldsw + _i * 8192), 16, 0, 0); } while (0)
#define PG8_LDA(dst, b, h) do { _Pragma("unroll") for (int m = 0; m < 4; ++m) _Pragma("unroll") for (int k = 0; k < 2; ++k) dst[m][k] = *(const PG8_LAS bf16x8*)(lds + PG8_SA(b, h) + aoff + m * 2048 + k * 1024); } while (0)
#define PG8_LDB(dst, b, h) do { _Pragma("unroll") for (int n = 0; n < 2; ++n) _Pragma("unroll") for (int k = 0; k < 2; ++k) dst[n][k] = *(const PG8_LAS bf16x8*)(lds + PG8_SB(b, h) + boff + n * 2048 + k * 1024); } while (0)
#define PG8_MMA(ai, bj, At, Bt) do { __builtin_amdgcn_s_setprio(1); _Pragma("unroll") for (int m = 0; m < 4; ++m) _Pragma("unroll") for (int n = 0; n < 2; ++n) _Pragma("unroll") for (int k = 0; k < 2; ++k) \
        acc[ai][bj][m][n] = __builtin_amdgcn_mfma_f32_16x16x32_bf16(Bt[n][k], At[m][k], acc[ai][bj][m][n], 0, 0, 0); __builtin_amdgcn_s_setprio(0); } while (0)
#define PG8_WAIT_V(n) asm volatile("s_waitcnt vmcnt(" #n ")" ::: "memory")
#define PG8_WAIT_L(n) asm volatile("s_waitcnt lgkmcnt(" #n ")" ::: "memory")
#define PG8_BAR __builtin_amdgcn_s_barrier()
#define PG8_SCHED __builtin_amdgcn_sched_barrier(0)
    Unit cur, nxt; int ui = 0;
    if (!S.next(0, cur)) return;
    f32x4 acc[2][2][4][2];
#pragma unroll
    for (int a = 0; a < 2; ++a)
#pragma unroll
        for (int b = 0; b < 2; ++b)
#pragma unroll
            for (int m = 0; m < 4; ++m)
#pragma unroll
                for (int n = 0; n < 2; ++n) acc[a][b][m][n] = (f32x4){0.f, 0.f, 0.f, 0.f};
    bf16x8 At[4][2], B0[2][2], B1[2][2];
    const char* cA = cur.a; const char* cB = cur.b;
    PG8_STAGE(PG8_SB(0, 0), cB, voffB); PG8_STAGE(PG8_SB(0, 1), cB + hstepB, voffB); PG8_STAGE(PG8_SA(0, 0), cA, voffA); PG8_STAGE(PG8_SA(0, 1), cA + hstepA, voffA);
    if (wr == 1) PG8_BAR;
    PG8_WAIT_V(2); PG8_BAR;
    PG8_STAGE(PG8_SB(1, 0), cB + kstepB, voffB); PG8_STAGE(PG8_SA(1, 0), cA + kstepA, voffA); PG8_STAGE(PG8_SB(1, 1), cB + hstepB + kstepB, voffB);
    PG8_WAIT_V(6); PG8_BAR;
    for (;;) {
        int nt = cur.nt; asm volatile("" : "+s"(nt));
        const bool has_next = S.next(ui + 1, nxt);
        const char* nA = has_next ? nxt.a : cA; const char* nB = has_next ? nxt.b : cB;
        for (int t = 0; t < nt; t += 2) {
            const bool last = (t == nt - 2);
            const char* a1 = cA + (size_t)(t + 1) * kstepA;
            const char* a2 = last ? nA : cA + (size_t)(t + 2) * kstepA; const char* b2 = last ? nB : cB + (size_t)(t + 2) * kstepB;
            const char* a3 = a2 + kstepA; const char* b3 = b2 + kstepB;
            PG8_LDB(B0, 0, 0); PG8_LDB(B1, 0, 1); PG8_SCHED; PG8_LDA(At, 0, 0); PG8_STAGE(PG8_SA(1, 1), a1 + hstepA, voffA);
            PG8_WAIT_V(8); PG8_WAIT_L(0); PG8_BAR; PG8_MMA(0, 0, At, B0); PG8_MMA(0, 1, At, B1); PG8_BAR; PG8_SCHED;
            PG8_LDA(At, 0, 1); PG8_STAGE(PG8_SB(0, 0), b2, voffB); PG8_STAGE(PG8_SB(0, 1), b2 + hstepB, voffB); PG8_STAGE(PG8_SA(0, 0), a2, voffA);
            PG8_WAIT_V(8); PG8_WAIT_L(0); PG8_BAR; PG8_MMA(1, 0, At, B0); PG8_MMA(1, 1, At, B1); PG8_BAR; PG8_SCHED;
            PG8_LDB(B0, 1, 0); PG8_LDB(B1, 1, 1); PG8_SCHED; PG8_LDA(At, 1, 0); PG8_STAGE(PG8_SA(0, 1), a2 + hstepA, voffA);
            PG8_WAIT_V(8); PG8_WAIT_L(0); PG8_BAR; PG8_MMA(0, 0, At, B0); PG8_MMA(0, 1, At, B1); PG8_BAR; PG8_SCHED;
            PG8_LDA(At, 1, 1); PG8_STAGE(PG8_SB(1, 0), b3, voffB); PG8_STAGE(PG8_SB(1, 1), b3 + hstepB, voffB); PG8_STAGE(PG8_SA(1, 0), a3, voffA);
            PG8_WAIT_V(8); PG8_WAIT_L(0); PG8_BAR; PG8_MMA(1, 0, At, B0); PG8_MMA(1, 1, At, B1); PG8_BAR; PG8_SCHED;
        }
        if constexpr (ALIGN_EPI) { if (wr == 0) PG8_BAR; }
        E(acc, cur, wr, wc, fr, fq);
        if (!has_next) break;
#pragma unroll
        for (int a = 0; a < 2; ++a)
#pragma unroll
            for (int b = 0; b < 2; ++b)
#pragma unroll
                for (int m = 0; m < 4; ++m)
#pragma unroll
                    for (int n = 0; n < 2; ++n) acc[a][b][m][n] = (f32x4){0.f, 0.f, 0.f, 0.f};
        cur = nxt; cA = nA; cB = nB; ++ui;
        if constexpr (ALIGN_EPI) { if (wr == 1) PG8_BAR; }
    }
    PG8_WAIT_V(0);
    if constexpr (!ALIGN_EPI) { if (wr == 0) PG8_BAR; }
    PG8_BAR;
#undef PG8_SA
#undef PG8_SB
#undef PG8_STAGE
#undef PG8_LDA
#undef PG8_LDB
#undef PG8_MMA
#undef PG8_WAIT_V
#undef PG8_WAIT_L
#undef PG8_BAR
#undef PG8_SCHED
}
}

#define XB_TMO      128
#define XB_XCNT(j)  (256  + 64 * (j))
#define XB_XSUB(j)  (1280 + 64 * (j))
#define XB_XGEN(j)  (2304 + 64 * (j))
#define XB_TOP      3328
#define XB_TOPGEN   3392
#define XCD_BAR_WORDS 3456
#define XB_SPIN_CAP (1u << 22)
__device__ __forceinline__ unsigned xb_ld(unsigned* p)              { return __hip_atomic_load(p, __ATOMIC_RELAXED, __HIP_MEMORY_SCOPE_AGENT); }
__device__ __forceinline__ unsigned xb_add(unsigned* p, unsigned v) { return __hip_atomic_fetch_add(p, v, __ATOMIC_RELAXED, __HIP_MEMORY_SCOPE_AGENT); }
__device__ __forceinline__ unsigned xb_xcc_id() { return (unsigned)__builtin_amdgcn_s_getreg((3 << 11) | 20) & 0xFu; }
#define XB_SPIN(cond, bar) do { unsigned _sp = 0; while (cond) { __builtin_amdgcn_s_sleep(1); \
    if ((++_sp & 255u) == 0u) { if (xb_ld(&(bar)[XB_TMO])) break; if (_sp > XB_SPIN_CAP) { atomicAdd(&(bar)[XB_TMO], 1u); break; } } } } while (0)
struct XcdBarrier { unsigned* bar; unsigned x; volatile LAS unsigned* st; };
__device__ __forceinline__ XcdBarrier xcd_barrier_post(unsigned* bar, volatile LAS unsigned* st) {
    XcdBarrier b; b.bar = bar; b.x = xb_xcc_id(); b.st = st;
    if (threadIdx.x == 0) (void)xb_add(&bar[XB_XCNT(b.x)], 1u);
    return b;
}
__device__ __forceinline__ void xcd_barrier_complete(unsigned* bar, unsigned x, unsigned& nloc, unsigned& nx) {
    const unsigned G = gridDim.x * gridDim.y * gridDim.z;
    unsigned sum, cnt, mine, sp = 0u;
    for (;;) {
        sum = 0u; cnt = 0u; mine = 0u;
#pragma unroll
        for (unsigned j = 0; j < 16; ++j) { const unsigned c = xb_ld(&bar[XB_XCNT(j)]); sum += c; cnt += (c > 0u) ? 1u : 0u; mine = (j == x) ? c : mine; }
        if (sum == G) break;
        __builtin_amdgcn_s_sleep(1);
        if ((++sp & 255u) == 0u) { if (xb_ld(&bar[XB_TMO])) break; if (sp > XB_SPIN_CAP) { atomicAdd(&bar[XB_TMO], 1u); break; } }
    }
    nloc = mine > 0u ? mine : 1u; nx = cnt > 0u ? cnt : 1u;
}
__device__ __forceinline__ void xcd_barrier(const XcdBarrier& b) {
    asm volatile("s_waitcnt vmcnt(0)" ::: "memory");
    __syncthreads();
    if (threadIdx.x == 0) {
        unsigned* bar = b.bar;
        __builtin_amdgcn_s_waitcnt(0);
        unsigned nloc = b.st[0], nx = b.st[1];
        if (nloc == 0u) { xcd_barrier_complete(bar, b.x, nloc, nx); b.st[0] = nloc; b.st[1] = nx; }
        const unsigned old = xb_add(&bar[XB_XSUB(b.x)], 1u);
        const unsigned gen = old / nloc;
        if (old + 1u == (gen + 1u) * nloc) {
            __builtin_amdgcn_fence(__ATOMIC_RELEASE, "agent");
            asm volatile("s_waitcnt vmcnt(0)" ::: "memory");
            const unsigned og = xb_add(&bar[XB_TOP], 1u);
            const unsigned tg = og / nx;
            if (og + 1u == (tg + 1u) * nx) xb_add(&bar[XB_TOPGEN], 1u);
            else XB_SPIN(xb_ld(&bar[XB_TOPGEN]) == tg, bar);
            __builtin_amdgcn_fence(__ATOMIC_ACQUIRE, "agent");
            xb_add(&bar[XB_XGEN(b.x)], 1u);
            asm volatile("s_waitcnt vmcnt(0)" ::: "memory");
        } else {
            XB_SPIN(xb_ld(&bar[XB_XGEN(b.x)]) == gen, bar);
            __builtin_amdgcn_fence(__ATOMIC_ACQUIRE, "agent");
            asm volatile("s_waitcnt vmcnt(0)" ::: "memory");
        }
    }
    __syncthreads();
}

constexpr int NWAVES = 8, NTHR = 512;
constexpr int RING_BYTES = 131072, MISC_OFF = RING_BYTES + 320, LDS_BYTES = 147456;
struct Args { const float* in[33]; float* out; unsigned char* ws; int ph_lo, ph_hi, rep, li; };
typedef const __attribute__((address_space(4))) Args* ArgP;
enum { I_X = 0, I_C = 1, I_CTX = 2, I_CCTX = 3, I_L0 = 4, I_WIN = 13, I_GWF = 14, I_GBF = 15, I_GWB = 16, I_GBB = 17, I_GNORM = 18, I_WOUT0 = 19, I_L1 = 20, I_WQKV = 29, I_RPB = 30, I_WOUT1 = 31, I_NOUT = 32 };

struct Ctx { unsigned char* lds; int tid, lane, wave, bx, G, gw, NGW; };

__device__ __forceinline__ void ada_units(ArgP a, const Ctx& c) {
    float* MODS = (float*)(a->ws + WS_MODS); float* red = (float*)c.lds;
    f32x4 w[16];
#define ADA_LOADS(UU) do { const int u_ = (UU), l_ = u_ / 1152, rem_ = u_ % 1152; const float* W_ = a->in[l_ ? I_L1 : I_L0] + (size_t)((rem_ & 15) * 128 + c.wave * 16) * NMODW + (rem_ >> 4) * 256 + 4 * c.lane; \
        _Pragma("unroll") for (int kk = 0; kk < 16; ++kk) w[kk] = *(const f32x4*)(W_ + (size_t)kk * NMODW); } while (0)
    if (c.bx < 2 * 72 * 16) ADA_LOADS(c.bx);
    for (int u = c.bx; u < 2 * 72 * 16; u += c.G) {
        const int l = u / 1152, rem = u % 1152, nb = rem >> 4, kc = rem & 15;
        const float* bias = a->in[(l ? I_L1 : I_L0) + 1];
        const int k0 = kc * 128 + c.wave * 16;
        float sv[5];
#pragma unroll
        for (int i = 0; i < 5; ++i) { const float* cv = i < 4 ? a->in[I_C] + i * D : a->in[I_CCTX]; sv[i] = silu_f(cv[k0 + (c.lane & 15)]); }
        f32x4 acc[5];
#pragma unroll
        for (int i = 0; i < 5; ++i) acc[i] = (f32x4){0.f, 0.f, 0.f, 0.f};
#pragma unroll
        for (int kk = 0; kk < 16; ++kk)
#pragma unroll
            for (int i = 0; i < 5; ++i) acc[i] += rdl(sv[i], kk) * w[kk];
#pragma unroll
        for (int i = 0; i < 5; ++i) *(f32x4*)(red + (c.wave * 5 + i) * 256 + 4 * c.lane) = acc[i];
        ADA_LOADS(u + c.G < 2 * 72 * 16 ? u + c.G : u);
        __syncthreads();
        for (int e = c.tid; e < 1280; e += NTHR) { const int i = e >> 8, n = e & 255; float sum = 0.f;
#pragma unroll
            for (int ww = 0; ww < 8; ++ww) sum += red[(ww * 5 + i) * 256 + n];
            if (kc == 0) sum += bias[nb * 256 + n];
            unsafeAtomicAdd(MODS + (size_t)(l * 5 + i) * NMODW + nb * 256 + n, sum); }
        __syncthreads();
    }
#undef ADA_LOADS
}
__device__ __forceinline__ void tables(ArgP a, const Ctx& c) {
    const int gt = c.bx * NTHR + c.tid, NT = c.G * NTHR;
    bf16* WA = (bf16*)(a->ws + WS_WA); bf16* WB = (bf16*)(a->ws + WS_WB);
    for (int it = gt; it < 2 * 256 * 16; it += NT) { const int wsel = it >> 12, row = (it >> 4) & 255, c0 = (it & 15) * 8, ri = c0 >> 6, t0 = c0 & 63, ai = row >> 7, rr = row & 127; float v[8];
#pragma unroll
        for (int j = 0; j < 8; ++j) { const float x = (float)(((t0 + j) * rr) & 63) * (1.f / 32.f), cs = cospif(x), sn = sinpif(x);
            v[j] = rr >= 64 ? 0.f : (wsel == 0 ? (ai == 0 ? (ri ? -sn : cs) : (ri ? cs : sn)) : (ai == 0 ? (ri ? -sn : cs) * (1.f / 1024.f) : 0.f)); }
        u32x4 w; w.x = pk2(v[0], v[1]); w.y = pk2(v[2], v[3]); w.z = pk2(v[4], v[5]); w.w = pk2(v[6], v[7]); *(u32x4*)((wsel ? WB : WA) + row * 128 + c0) = w; }
    f32x2* TWt = (f32x2*)(a->ws + WS_TW);
    for (int it = gt; it < 64 * 64; it += NT) { const float x = (float)(((it >> 6) * (it & 63)) & 4095) * (1.f / 2048.f); TWt[it] = (f32x2){cospif(x), sinpif(x)}; }
    bf16* DC = (bf16*)(a->ws + WS_DFTC);
    for (int it = gt; it < 512 * 32; it += NT) { const int row = it >> 5, c0 = (it & 31) * 8, cs = row >> 8, cp = row & 255; float v[8];
#pragma unroll
        for (int j = 0; j < 8; ++j) { const int idx = ((c0 + j) * cp) & 255; const float x = (float)idx * (1.f / 128.f); v[j] = cs ? sinpif(x) : cospif(x); }
        u32x4 w; w.x = pk2(v[0], v[1]); w.y = pk2(v[2], v[3]); w.z = pk2(v[4], v[5]); w.w = pk2(v[6], v[7]); *(u32x4*)(DC + (size_t)row * 256 + c0) = w; }
    bf16* D2 = (bf16*)(a->ws + WS_DFT256);
    for (int it = gt; it < 256 * 64; it += NT) { const int tp = it >> 6, c0 = (it & 63) * 8, cs = c0 >> 8, t0 = c0 & 255; float v[8];
#pragma unroll
        for (int j = 0; j < 8; ++j) { const int idx = ((t0 + j) * tp) & 255; const float x = (float)idx * (1.f / 128.f); v[j] = (cs ? -sinpif(x) : cospif(x)) * (1.f / 256.f); }
        u32x4 w; w.x = pk2(v[0], v[1]); w.y = pk2(v[2], v[3]); w.z = pk2(v[4], v[5]); w.w = pk2(v[6], v[7]); *(u32x4*)(D2 + (size_t)tp * 512 + c0) = w; }
    f32x2* RP = (f32x2*)(a->ws + WS_ROPE);
    for (int it = gt; it < 64 * 32; it += NT) { const int pos = it >> 5, i = it & 31; const float inv = powf(10000.f, -(float)i / 32.f), ang = (float)pos * inv; RP[it] = (f32x2){cosf(ang), sinf(ang)}; }
}

__device__ __forceinline__ int src_col0(int type, int n0) {
    if (type == 1) { const int pn = n0 >> 8, rem = n0 & 255, bj = rem >> 7, j = rem & 127; return bj * FF + pn * 128 + j; }
    if (type == 2) { return n0 < 2048 ? n0 : (n0 < 4096 ? n0 + 32 : (n0 == 4096 ? 2048 : -1)); }
    return n0;
}
__device__ __forceinline__ void tr_load(f32x4 (&v)[8], const float* W, int Nsrc, int sn0, int k0, int lane) {
    const float* p = W + (size_t)(k0 + 8 * (lane >> 3)) * Nsrc + sn0 + 4 * (lane & 7);
#pragma unroll
    for (int j = 0; j < 8; ++j) v[j] = sn0 >= 0 ? *(const f32x4*)(p + (size_t)j * Nsrc) : (f32x4){0.f, 0.f, 0.f, 0.f};
}
__device__ __forceinline__ void tr_store(const f32x4 (&v)[8], bf16* WT, int K, int dn0, int k0, int lane) {
    const int n = dn0 + 4 * (lane & 7); bf16* p = WT + (((size_t)(n >> 8) * (K >> 6) + (k0 >> 6)) * 256 + (n & 255)) * 64 + 8 * (lane >> 3);
#pragma unroll
    for (int e = 0; e < 4; ++e) { u32x4 o; o.x = pk2(v[0][e], v[1][e]); o.y = pk2(v[2][e], v[3][e]); o.z = pk2(v[4][e], v[5][e]); o.w = pk2(v[6][e], v[7][e]); *(u32x4*)(p + (size_t)e * 64) = o; }
}
__device__ __forceinline__ void convert_matrix(const float* W, int K, int Nsrc, int Ndst, int type, bf16* WT, const Ctx& c) {
    const int nblk = Ndst / 32, nitems = (K / 64) * nblk;
    for (int it = c.gw; it < nitems; it += 2 * c.NGW) { const int it2 = it + c.NGW; const bool two = it2 < nitems;
        const int kb = it / nblk, nb = it % nblk, kb2 = two ? it2 / nblk : kb, nb2 = two ? it2 % nblk : nb;
        f32x4 v0[8], v1[8];
        tr_load(v0, W, Nsrc, src_col0(type, nb * 32), kb * 64, c.lane); tr_load(v1, W, Nsrc, src_col0(type, nb2 * 32), kb2 * 64, c.lane);
        tr_store(v0, WT, K, nb * 32, kb * 64, c.lane); if (two) tr_store(v1, WT, K, nb2 * 32, kb2 * 64, c.lane); }
}
__device__ __forceinline__ void convert_layer(ArgP a, const Ctx& c, int l) {
    const int base = l ? I_L1 : I_L0;
    convert_matrix(a->in[base + 5], D, 2 * FF, 2 * FF, 1, (bf16*)(a->ws + W_GU1), c);
    convert_matrix(a->in[base + 7], D, 2 * FF, 2 * FF, 1, (bf16*)(a->ws + W_GU2), c);
    convert_matrix(a->in[base + 6], FF, D, D, 0, (bf16*)(a->ws + W_D1), c);
    convert_matrix(a->in[base + 8], FF, D, D, 0, (bf16*)(a->ws + W_D2), c);
    if (l == 0) convert_matrix(a->in[I_WIN], D, 4128, ZW, 2, (bf16*)(a->ws + W_MIXA), c);
    else        convert_matrix(a->in[I_WQKV], D, QW, QW, 0, (bf16*)(a->ws + W_MIXA), c);
    convert_matrix(a->in[l ? I_WOUT1 : I_WOUT0], D, D, D, 0, (bf16*)(a->ws + W_OUT), c);
}

__device__ __forceinline__ void norm_row(const float* xr, bf16* Ub, int row, const f32x4 (&ca)[8], const f32x4 (&cb)[8], int lane) {
    f32x4 v[8]; float s = 0.f;
#pragma unroll
    for (int j = 0; j < 8; ++j) { v[j] = *(const f32x4*)(xr + 4 * lane + 256 * j); s += (v[j].x * v[j].x + v[j].y * v[j].y) + (v[j].z * v[j].z + v[j].w * v[j].w); }
    const float rstd = 1.f / sqrtf(wave_sum(s) * (1.f / D) + RMS_EPS);
#pragma unroll
    for (int j = 0; j < 8; ++j) { const f32x4 o = v[j] * rstd * ca[j] + cb[j]; u32x2 w; w.x = pk2(o.x, o.y); w.y = pk2(o.z, o.w); const int k = 4 * lane + 256 * j;
        *(u32x2*)(Ub + (((size_t)(row >> 8) * (D / 64) + (k >> 6)) * 256 + (row & 255)) * 64 + (k & 63)) = w; }
}
__device__ __forceinline__ void norm_mod_phase(const Ctx& c, const float* lat, const float* ctx, const float* gain, const float* mods, int jsub, bf16* U, bool with_ctx, float* ctx_copy, const float* slabs) {
    for (int vb = c.bx; vb < 256; vb += c.G) {
        f32x4 ca[8], cb[8];
        { const float* sh = mods + (size_t)(vb >> 6) * NMODW + (3 * jsub) * D; const float* sc = sh + D;
#pragma unroll
          for (int j = 0; j < 8; ++j) { const int k = 4 * c.lane + 256 * j; ca[j] = *(const f32x4*)(gain + k) * (*(const f32x4*)(sc + k) + 1.f); cb[j] = *(const f32x4*)(sh + k); } }
        for (int r = 0; r < 8; ++r) { const int row = 64 * vb + 8 * c.wave + r; norm_row(lat + (size_t)row * D, U, row, ca, cb, c.lane); }
        if (with_ctx && c.wave < 4) {
            const float* sh = mods + (size_t)NB * NMODW + (3 * jsub) * D; const float* sc = sh + D;
#pragma unroll
            for (int j = 0; j < 8; ++j) { const int k = 4 * c.lane + 256 * j; ca[j] = *(const f32x4*)(gain + k) * (*(const f32x4*)(sc + k) + 1.f); cb[j] = *(const f32x4*)(sh + k); }
            const int row = 4 * vb + c.wave; float* xr = (float*)ctx + (size_t)row * D;
            if (slabs) {
#pragma unroll
                for (int j = 0; j < 8; ++j) { const size_t o = (size_t)row * D + 4 * c.lane + 256 * j; f32x4 v = *(const f32x4*)(ctx + o);
#pragma unroll
                    for (int q = 0; q < 4; ++q) v += *(const f32x4*)(slabs + (size_t)q * MC * D + o);
                    *(f32x4*)(xr + 4 * c.lane + 256 * j) = v; }
                asm volatile("s_waitcnt vmcnt(0)" ::: "memory"); }
            norm_row(ctx + (size_t)row * D, U, ML + row, ca, cb, c.lane);
            if (ctx_copy) { f32x4 cv[8];
#pragma unroll
                for (int j = 0; j < 8; ++j) cv[j] = *(const f32x4*)(ctx + (size_t)row * D + 4 * c.lane + 256 * j);
#pragma unroll
                for (int j = 0; j < 8; ++j) *(f32x4*)(ctx_copy + (size_t)row * D + 4 * c.lane + 256 * j) = cv[j]; }
        }
    }
}

struct Fn1Sched {
    int G, c; const char* dftc; const char* Z;
    __device__ __forceinline__ bool next(int i, pg8::Unit& u) const {
        const int L = i * G + c; if (L >= 512) return false;
        u.pm = 0; u.pn = 0; u.sc = 1.f; u.nt = 4; u.flags = 8;
        const int j = L & 15, ri = (L >> 4) & 1, g = (L >> 5) & 3, b = L >> 7;
        u.a = dftc + (size_t)ri * 256 * 256 * 2; u.b = Z + ((size_t)(b * T + 4 * j) * ZW + 3072 + g * 256) * 2;
        u.ooff = (long)((size_t)(b * 1024 + g * 256) * 8192 + 4 * j * 128 + ri * 64); u.ldc = 8192; return true;
    }
};
struct Fn1cSched {
    int G, c; const char* dftc; const char* Z;
    __device__ __forceinline__ bool next(int i, pg8::Unit& u) const {
        const int L = i * G + c; if (L >= 32) return false;
        u.pm = 0; u.pn = 0; u.sc = 1.f; u.nt = 4; u.flags = 0;
        const int cs = L & 1, g = (L >> 1) & 3, b = L >> 3;
        u.a = dftc + (size_t)cs * 256 * 256 * 2; u.b = Z + ((size_t)(ML + b * TC) * ZW + 3072 + g * 256) * 2;
        u.ooff = (long)((WS_F1TC - WS_F1T) / 2 + (size_t)(b * 1024 + g * 256) * 512 + cs * 256); u.ldc = 512; return true;
    }
};
struct FabSched {
    int G, c; const char* w; const char* x;
    __device__ __forceinline__ bool next(int i, pg8::Unit& u) const {
        const int L = i * G + c; if (L >= 1024) return false;
        u.pm = 0; u.pn = L; u.sc = 1.f; u.nt = 2; u.flags = 0; u.ooff = 0; u.ldc = 0; u.a = w; u.b = x + (size_t)L * 256 * 128 * 2; return true;
    }
};
struct Fn2cSched {
    int G, c; const char* dft; const char* f1tc;
    __device__ __forceinline__ bool next(int i, pg8::Unit& u) const {
        const int L = i * G + c; if (L >= 16) return false;
        const int b = L >> 2, pn = L & 3;
        u.pm = 0; u.pn = pn; u.sc = 1.f; u.nt = 8; u.flags = 0; u.a = dft; u.b = f1tc + (size_t)(b * 1024 + pn * 256) * 512 * 2;
        u.ooff = (long)((size_t)(ML + b * TC) * D + 1024 + pn * 256); u.ldc = D; return true;
    }
};
struct StoreSched {
    pg8::PlainSched p; int ldc, nscale; float sc0;
    __device__ __forceinline__ bool next(int i, pg8::Unit& u) const { if (!p.next(i, u)) return false; u.ooff = (long)((size_t)u.pm * 256 * ldc + u.pn * 256); u.ldc = ldc; u.sc = u.pn < nscale ? sc0 : 1.f; return true; }
};

struct ResidSched {
    pg8::TileOrder to; int G, c, ntk, npieces, ksa; const char* A; const char* Bt; size_t a_t, b_t;
    __device__ __forceinline__ void init(const void* A_, int lda, const void* Bt_, int ldb, int K, bool with_ctx, int G_, int c_, int ksa_ = 128) { ksa = ksa_; to.init(ML / 256, 8); G = G_; c = c_; ntk = K / 64; npieces = with_ctx ? 128 : 0;
        A = (const char*)A_; Bt = (const char*)Bt_; a_t = (size_t)256 * lda * 2; b_t = (size_t)256 * ldb * 2; }
    __device__ __forceinline__ bool next(int i, pg8::Unit& u) const {
        const int L = i * G + c; u.ooff = 0; u.ldc = 0; u.sc = 1.f;
        if (L < 512) { to.decode(L, u.pm, u.pn); u.a = A + (size_t)u.pm * a_t; u.b = Bt + (size_t)u.pn * b_t; u.nt = ntk; u.flags = 0; return true; }
        const int piece = L - 512; if (piece >= npieces) return false;
        const int idx = piece >> 3, pair = (piece & 7) * 2 + (idx >> 3), kq = pair & 3, ntp = ntk >> 2;
        u.pn = idx & 7; u.pm = ML / 256 + (pair >> 2); u.nt = ntp; u.flags = 1 | (kq << 1);
        u.a = A + (size_t)u.pm * a_t + (size_t)kq * ntp * ksa; u.b = Bt + (size_t)u.pn * b_t + (size_t)kq * ntp * 32768; return true;
    }
};
struct QkvSched {
    int G, c; const char* U; const char* W;
    __device__ __forceinline__ bool next(int i, pg8::Unit& u) const {
        int L = i * G + c; if (L >= 1632) return false;
        u.nt = D / 64; u.flags = 0;
        if (L < 1088) { pg8::TileOrder to; to.init(MT / 256, 16); to.decode(L, u.pm, u.pn); u.a = U + (size_t)u.pm * 256 * D * 2; u.b = W + (size_t)u.pn * 256 * D * 2;
            u.ooff = 0; u.ldc = 0; u.sc = u.pn < 8 ? 0.125f * 1.4426950408889634f : 1.f; }
        else { L -= 1088; pg8::TileOrder to; to.init(8, MT / 256); to.decode(L, u.pm, u.pn); u.a = W + (size_t)(16 + u.pm) * 256 * D * 2; u.b = U + (size_t)u.pn * 256 * D * 2;
            u.ooff = 0; u.ldc = 0; u.sc = 1.f; u.flags = 2; }
        return true;
    }
};

typedef float f32x16 __attribute__((ext_vector_type(16)));
#define MFMA32(a, b, c) __builtin_amdgcn_mfma_f32_32x32x16_bf16((a), (b), (c), 0, 0, 0)
constexpr int GLA_NC = 68, GLA_UNITS = 16 * GLA_NC;
__device__ __forceinline__ int gla_row0(int b, int cn) { return cn < 4 ? ML + b * TC + cn * 64 : b * T + (cn - 4) * 64; }
__device__ __forceinline__ float logsig16(float x) { return (fminf(x, 0.f) - 0.6931471805599453f * __builtin_amdgcn_logf(1.f + __expf(-fabsf(x)))) * (1.f / 16.f); }
__device__ __forceinline__ void gla_a_phase(ArgP a, const Ctx& c) {
    unsigned char* L = c.lds;
    float* LR = (float*)L; float* TOT = (float*)(L + 8192);
    bf16* QF = (bf16*)(L + 12288); bf16* KF = QF + 64 * 136; bf16* QB = KF + 64 * 136; bf16* KB = QB + 64 * 136;
    bf16* K2TF = (bf16*)(L + 81920); bf16* K2TB = (bf16*)(L + 100352);
    bf16* VT = (bf16*)(L + 12288);
    const bf16* Z = (const bf16*)(a->ws + WS_BIG); const f32x2* RP = (const f32x2*)(a->ws + WS_ROPE);
    bf16* QP = (bf16*)(a->ws + WS_QP); bf16* ATT = (bf16*)(a->ws + WS_ATT); bf16* DST = (bf16*)(a->ws + WS_DST); float* AD = (float*)(a->ws + WS_AD);
    const int kk = c.tid & 127, grp = c.tid >> 7, l32 = c.lane & 31, hh = c.lane >> 5;
    float wf[16], wb[16], biasf = 0.f, biasb = 0.f; u32x4 qkraw[4]; bf16 lrv[4]; bf16x8 vraw[4];
#define GLA_A_LOADS(UU) do { const int u_ = (UU), bh_ = u_ / GLA_NC, cn_ = u_ % GLA_NC, h_ = bh_ & 3, row0_ = gla_row0(bh_ >> 2, cn_); \
        _Pragma("unroll") for (int i = 0; i < 4; ++i) { const int e = c.tid + 512 * i; lrv[i] = Z[(size_t)(row0_ + (e >> 5)) * ZW + 4096 + (e & 31)]; } \
        _Pragma("unroll") for (int j = 0; j < 16; ++j) { wf[j] = a->in[I_GWF][j * 512 + h_ * 128 + kk]; wb[j] = a->in[I_GWB][j * 512 + h_ * 128 + kk]; } \
        _Pragma("unroll") for (int i = 0; i < 2; ++i) { const int ch = c.tid + 512 * i; const bf16* z = Z + (size_t)(row0_ + (ch >> 4)) * ZW + h_ * 128 + (ch & 15) * 8; qkraw[i] = *(const u32x4*)z; qkraw[2 + i] = *(const u32x4*)(z + 512); } \
        _Pragma("unroll") for (int i = 0; i < 4; ++i) { const int p = c.tid + 512 * i; vraw[i] = *(const bf16x8*)(Z + (size_t)(row0_ + (p & 7) + 8 * (p >> 8)) * ZW + 1024 + h_ * 256 + ((p >> 3) & 31) * 8); }     \
        biasf = a->in[I_GBF][h_ * 128 + kk]; biasb = a->in[I_GBB][h_ * 128 + kk]; } while (0)
    const float invf = __builtin_amdgcn_exp2f(-(float)(kk & 31) * (13.287712379549449f / 32.f)) * 0.15915494309189535f;
    if (c.bx < GLA_UNITS) GLA_A_LOADS(c.bx);
    for (int u = c.bx; u < GLA_UNITS; u += c.G) {
        const int bh = u / GLA_NC, cn = u % GLA_NC, b = bh >> 2, h = bh & 3, row0 = gla_row0(b, cn);
#pragma unroll
        for (int i = 0; i < 4; ++i) LR[c.tid + 512 * i] = bf2f(lrv[i]);
#pragma unroll
        for (int i = 0; i < 2; ++i) { const int ch = c.tid + 512 * i, o = (ch >> 4) * 136 + (ch & 15) * 8; *(u32x4*)(QF + o) = qkraw[i]; *(u32x4*)(KF + o) = qkraw[2 + i]; }
        __syncthreads();
        float gf[16], gb[16];
#pragma unroll
        for (int i = 0; i < 16; ++i) { const float* lr = LR + (16 * grp + i) * 32; float pf = biasf, pb = biasb;
#pragma unroll
            for (int j = 0; j < 16; ++j) { pf += lr[j] * wf[j]; pb += lr[16 + j] * wb[j]; }
            gf[i] = logsig16(pf); gb[i] = logsig16(pb); }
#pragma unroll
        for (int i = 1; i < 16; ++i) gf[i] += gf[i - 1];
#pragma unroll
        for (int i = 14; i >= 0; --i) gb[i] += gb[i + 1];
        TOT[grp * 128 + kk] = gf[15]; TOT[(4 + grp) * 128 + kk] = gb[0];
        __syncthreads();
        float offf = 0.f, offb = 0.f, lastf = 0.f, firstb = 0.f;
#pragma unroll
        for (int g = 0; g < 4; ++g) { const float tf = TOT[g * 128 + kk], tb = TOT[(4 + g) * 128 + kk]; lastf += tf; firstb += tb; if (g < grp) offf += tf; if (g > grp) offb += tb; }
        const float Elast = __expf(lastf), Efirst = __expf(firstb);
        float k2f[16], k2b[16];
#pragma unroll
        for (int i = 0; i < 16; ++i) { const int t = 16 * grp + i;
            float qv = bf2f(QF[t * 136 + kk]), kv = bf2f(KF[t * 136 + kk]);
            if (cn >= 4) { float fpos = (float)((kk & 64) ? t : (cn - 4)); asm volatile("" : "+v"(fpos));
                const float ang = fpos * invf; const f32x2 cs = (f32x2){__builtin_amdgcn_cosf(ang), __builtin_amdgcn_sinf(ang)};   const float qo = __shfl_xor(qv, 32), ko = __shfl_xor(kv, 32);
                if (kk & 32) { qv = qo * cs.y + qv * cs.x; kv = ko * cs.y + kv * cs.x; } else { qv = qv * cs.x - qo * cs.y; kv = kv * cs.x - ko * cs.y; } }
            qv *= 0.08838834764831845f;
            const float ef = __expf(gf[i] + offf), eb = __expf(gb[i] + offb), ief = __builtin_amdgcn_rcpf(ef), ieb = __builtin_amdgcn_rcpf(eb);
            const bf16 qf_ = (bf16)f2bf(qv * ef), qb_ = (bf16)f2bf(qv * eb);
            QF[t * 136 + kk] = qf_; KF[t * 136 + kk] = (bf16)f2bf(kv * ief); QB[t * 136 + kk] = qb_; KB[t * 136 + kk] = (bf16)f2bf(kv * ieb);
            QP[((size_t)u * 64 + t) * 256 + kk] = qf_; QP[((size_t)u * 64 + t) * 256 + 128 + kk] = qb_;
            k2f[i] = kv * ief * Elast; k2b[i] = kv * ieb * Efirst; }
        { u32x4 w0, w1;
          w0.x = pk2(k2f[0], k2f[1]); w0.y = pk2(k2f[2], k2f[3]); w0.z = pk2(k2f[4], k2f[5]); w0.w = pk2(k2f[6], k2f[7]); w1.x = pk2(k2f[8], k2f[9]); w1.y = pk2(k2f[10], k2f[11]); w1.z = pk2(k2f[12], k2f[13]); w1.w = pk2(k2f[14], k2f[15]);
          *(u32x4*)(K2TF + kk * 72 + 16 * grp) = w0; *(u32x4*)(K2TF + kk * 72 + 16 * grp + 8) = w1;
          w0.x = pk2(k2b[0], k2b[1]); w0.y = pk2(k2b[2], k2b[3]); w0.z = pk2(k2b[4], k2b[5]); w0.w = pk2(k2b[6], k2b[7]); w1.x = pk2(k2b[8], k2b[9]); w1.y = pk2(k2b[10], k2b[11]); w1.z = pk2(k2b[12], k2b[13]); w1.w = pk2(k2b[14], k2b[15]);
          *(u32x4*)(K2TB + kk * 72 + 16 * grp) = w0; *(u32x4*)(K2TB + kk * 72 + 16 * grp + 8) = w1; }
        if (grp == 0) { AD[((size_t)u * 2 + 0) * 128 + kk] = Elast; AD[((size_t)u * 2 + 1) * 128 + kk] = Efirst; }
        __syncthreads();
        if (c.wave < 4) {
            const int ti = c.wave >> 1, si = c.wave & 1; f32x16 accF, accB;
#pragma unroll
            for (int r = 0; r < 16; ++r) { accF[r] = 0.f; accB[r] = 0.f; }
#pragma unroll
            for (int s = 0; s < 8; ++s) { const int ko = 16 * s + 8 * hh;
                accF = MFMA32(*(const bf16x8*)(KF + (32 * si + l32) * 136 + ko), *(const bf16x8*)(QF + (32 * ti + l32) * 136 + ko), accF);
                accB = MFMA32(*(const bf16x8*)(KB + (32 * si + l32) * 136 + ko), *(const bf16x8*)(QB + (32 * ti + l32) * 136 + ko), accB); }
            const int t = 32 * ti + l32;
#pragma unroll
            for (int g = 0; g < 4; ++g) { float v[4];
#pragma unroll
                for (int e = 0; e < 4; ++e) { const int s_ = 32 * si + 8 * g + 4 * hh + e; v[e] = (s_ <= t ? accF[4 * g + e] : 0.f) + (s_ >= t ? accB[4 * g + e] : 0.f); }
                u32x2 w; w.x = pk2(v[0], v[1]); w.y = pk2(v[2], v[3]); *(u32x2*)(ATT + ((size_t)u * 64 + t) * 64 + 32 * si + 8 * g + 4 * hh) = w; }
        }
        __syncthreads();
#pragma unroll
        for (int i = 0; i < 4; ++i) { const int p = c.tid + 512 * i, t = (p & 7) + 8 * (p >> 8), vb = (p >> 3) & 31, tc = (((t >> 3) ^ (vb & 7)) << 3) + (t & 7); const bf16x8 vv = vraw[i];
#pragma unroll
            for (int e = 0; e < 8; ++e) VT[(vb * 8 + e) * 72 + tc] = (bf16)vv[e]; }
        __syncthreads();
        if (u + c.G < GLA_UNITS) GLA_A_LOADS(u + c.G);
        { const int dir = c.wave >> 2, mt = c.wave & 3; const bf16* K2T = dir ? K2TB : K2TF; bf16x8 af[4];
#pragma unroll
          for (int s = 0; s < 4; ++s) af[s] = *(const bf16x8*)(K2T + (32 * mt + l32) * 72 + 16 * s + 8 * hh);
          for (int nt = 0; nt < 8; ++nt) { f32x16 acc;
#pragma unroll
              for (int r = 0; r < 16; ++r) acc[r] = 0.f;
#pragma unroll
              for (int s = 0; s < 4; ++s) acc = MFMA32(af[s], *(const bf16x8*)(VT + (32 * nt + l32) * 72 + (((2 * s + hh) ^ (4 * (nt & 1) + (l32 >> 3))) << 3)), acc);
              bf16* dp = DST + ((size_t)u * 2 + dir) * 32768 + (size_t)(((nt * 4 + mt) * 2) * 64 + c.lane) * 8;
#pragma unroll
              for (int hf = 0; hf < 2; ++hf) { u32x4 w; w.x = pk2(acc[8 * hf], acc[8 * hf + 1]); w.y = pk2(acc[8 * hf + 2], acc[8 * hf + 3]); w.z = pk2(acc[8 * hf + 4], acc[8 * hf + 5]); w.w = pk2(acc[8 * hf + 6], acc[8 * hf + 7]);
                  *(u32x4*)(dp + hf * 512) = w; } } }
        __syncthreads();
    }
#undef GLA_A_LOADS
}
__device__ __forceinline__ void gla_b_phase(ArgP a, const Ctx& c) {
    bf16* DST = (bf16*)(a->ws + WS_DST); const float* AD = (const float*)(a->ws + WS_AD);
    for (int item = c.bx * NTHR + c.tid; item < 32 * 4096; item += c.G * NTHR) {
        const int bhd = item >> 12, rem = item & 4095, bh = bhd >> 1, dir = bhd & 1, kA = 32 * ((rem >> 7) & 3) + 16 * ((rem >> 6) & 1) + 4 * ((rem >> 5) & 1);
        float S[8];
#pragma unroll
        for (int e = 0; e < 8; ++e) S[e] = 0.f;
#define GLA_B_GROUP(J0, DEPTH) do { u32x4 d[DEPTH]; f32x4 a0[DEPTH], a1[DEPTH]; bf16* p[DEPTH]; \
            _Pragma("unroll") for (int jj = 0; jj < DEPTH; ++jj) { const int j = (J0) + jj, cn = dir ? (j < 4 ? 3 - j : 71 - j) : j; const size_t ud = ((size_t)bh * GLA_NC + cn) * 2 + dir; \
                p[jj] = DST + ud * 32768 + rem * 8; d[jj] = *(const u32x4*)p[jj]; a0[jj] = *(const f32x4*)(AD + ud * 128 + kA); a1[jj] = *(const f32x4*)(AD + ud * 128 + kA + 8); } \
            _Pragma("unroll") for (int jj = 0; jj < DEPTH; ++jj) { u32x4 o; o.x = pk2(S[0], S[1]); o.y = pk2(S[2], S[3]); o.z = pk2(S[4], S[5]); o.w = pk2(S[6], S[7]); *(u32x4*)p[jj] = o; \
                const unsigned dw[4] = {d[jj].x, d[jj].y, d[jj].z, d[jj].w}; \
                _Pragma("unroll") for (int e = 0; e < 4; ++e) { S[2 * e] = S[2 * e] * (e < 2 ? a0[jj][2 * e] : a1[jj][2 * e - 4]) + __builtin_bit_cast(float, dw[e] << 16); \
                                              S[2 * e + 1] = S[2 * e + 1] * (e < 2 ? a0[jj][2 * e + 1] : a1[jj][2 * e - 3]) + __builtin_bit_cast(float, dw[e] & 0xffff0000u); } } } while (0)
        for (int j0 = 0; j0 < 64; j0 += 8) GLA_B_GROUP(j0, 8);
        GLA_B_GROUP(64, 4);
#undef GLA_B_GROUP
    }
}
__device__ __forceinline__ bf16x8 qp_perm(const bf16* p) { const u32x2 lo = *(const u32x2*)p, hi = *(const u32x2*)(p + 8); u32x4 w; w.x = lo.x; w.y = lo.y; w.z = hi.x; w.w = hi.y; return __builtin_bit_cast(bf16x8, w); }
__device__ __forceinline__ void gla_c_phase(ArgP a, const Ctx& c) {
    unsigned char* L = c.lds;
    bf16* QPL = (bf16*)L; bf16* ATTL = (bf16*)(L + 33792); bf16* VT = (bf16*)(L + 43008); float* RED = (float*)(L + 79872);
    const bf16* Z = (const bf16*)(a->ws + WS_BIG); const bf16* QP = (const bf16*)(a->ws + WS_QP); const bf16* ATT = (const bf16*)(a->ws + WS_ATT); const bf16* ST = (const bf16*)(a->ws + WS_DST);
    bf16* MIX = (bf16*)(a->ws + WS_MIX); const float* gn = a->in[I_GNORM];
    const int l32 = c.lane & 31, hh = c.lane >> 5, w = c.wave;
    bf16x8 sfr[8], sbr[8];
#define GLA_C_SLOADS(UU) do { const bf16* SF_ = ST + (size_t)(UU) * 2 * 32768 + (size_t)(w * 8 * 64 + c.lane) * 8; \
        _Pragma("unroll") for (int s = 0; s < 8; ++s) { sfr[s] = *(const bf16x8*)(SF_ + 512 * s); sbr[s] = *(const bf16x8*)(SF_ + 32768 + 512 * s); } } while (0)
    if (c.bx < GLA_UNITS) GLA_C_SLOADS(c.bx);
    for (int u = c.bx; u < GLA_UNITS; u += c.G) {
        const int bh = u / GLA_NC, cn = u % GLA_NC, b = bh >> 2, h = bh & 3, row0 = gla_row0(b, cn);
        bf16x4 rvr[2][4];
#pragma unroll
        for (int nt = 0; nt < 2; ++nt)
#pragma unroll
            for (int g = 0; g < 4; ++g) rvr[nt][g] = *(const bf16x4*)(Z + (size_t)(row0 + 32 * nt + l32) * ZW + 2048 + h * 256 + 32 * w + 8 * g + 4 * hh);
        f32x4 g4v[4];
#pragma unroll
        for (int g = 0; g < 4; ++g) g4v[g] = *(const f32x4*)(gn + h * 256 + 32 * w + 8 * g + 4 * hh);
#pragma unroll
        for (int i = 0; i < 4; ++i) { const int p = c.tid + 512 * i, t = p >> 5, c8 = (p & 31) * 8; *(u32x4*)(QPL + t * 264 + c8) = *(const u32x4*)(QP + ((size_t)u * 64 + t) * 256 + c8); }
        { const int t = c.tid >> 3, c8 = (c.tid & 7) * 8; *(u32x4*)(ATTL + t * 72 + c8) = *(const u32x4*)(ATT + ((size_t)u * 64 + t) * 64 + c8); }
#pragma unroll
        for (int i = 0; i < 4; ++i) { const int p = c.tid + 512 * i, t = (p & 7) + 8 * (p >> 8), vb = (p >> 3) & 31, tc = (((t >> 3) ^ (vb & 7)) << 3) + (t & 7); const bf16x8 vv = *(const bf16x8*)(Z + (size_t)(row0 + t) * ZW + 1024 + h * 256 + vb * 8);
#pragma unroll
            for (int e = 0; e < 8; ++e) VT[(vb * 8 + e) * 72 + tc] = (bf16)vv[e]; }
        __syncthreads();
        f32x16 acc[2];
#pragma unroll
        for (int r = 0; r < 16; ++r) { acc[0][r] = 0.f; acc[1][r] = 0.f; }
#pragma unroll
        for (int s = 0; s < 8; ++s) { const bf16x8 af = sfr[s];
#pragma unroll
            for (int nt = 0; nt < 2; ++nt) acc[nt] = MFMA32(af, qp_perm(QPL + (32 * nt + l32) * 264 + 16 * s + 4 * hh), acc[nt]); }
#pragma unroll
        for (int s = 0; s < 8; ++s) { const bf16x8 af = sbr[s];
#pragma unroll
            for (int nt = 0; nt < 2; ++nt) acc[nt] = MFMA32(af, qp_perm(QPL + (32 * nt + l32) * 264 + 128 + 16 * s + 4 * hh), acc[nt]); }
#pragma unroll
        for (int s = 0; s < 4; ++s) { const bf16x8 af = *(const bf16x8*)(VT + (32 * w + l32) * 72 + (((2 * s + hh) ^ (4 * (w & 1) + (l32 >> 3))) << 3));
#pragma unroll
            for (int nt = 0; nt < 2; ++nt) acc[nt] = MFMA32(af, *(const bf16x8*)(ATTL + (32 * nt + l32) * 72 + 16 * s + 8 * hh), acc[nt]); }
#pragma unroll
        for (int nt = 0; nt < 2; ++nt) { float ss = 0.f;
#pragma unroll
            for (int r = 0; r < 16; ++r) ss += acc[nt][r] * acc[nt][r];
            ss += __shfl_xor(ss, 32); if (c.lane < 32) RED[w * 64 + 32 * nt + c.lane] = ss; }
        GLA_C_SLOADS(u + c.G < GLA_UNITS ? u + c.G : u);
        __syncthreads();
#pragma unroll
        for (int nt = 0; nt < 2; ++nt) { const int t = 32 * nt + l32; float tot = 0.f;
#pragma unroll
            for (int ww = 0; ww < 8; ++ww) tot += RED[ww * 64 + t];
            const float rstd = 1.f / sqrtf(tot * (1.f / 256.f) + RMS_EPS); const size_t row = (size_t)(row0 + t);
#pragma unroll
            for (int g = 0; g < 4; ++g) { const int v0 = 32 * w + 8 * g + 4 * hh; const bf16x4 rv = rvr[nt][g]; const f32x4 g4 = g4v[g]; float o[4];
#pragma unroll
                for (int e = 0; e < 4; ++e) o[e] = acc[nt][4 * g + e] * rstd * g4[e] * silu_f(bf2f((unsigned short)rv[e]));
                u32x2 wv; wv.x = pk2(o[0], o[1]); wv.y = pk2(o[2], o[3]); *(u32x2*)(MIX + row * D + h * 256 + v0) = wv; } }
        __syncthreads();
    }
#undef GLA_C_SLOADS
}

constexpr float LOG2E = 1.4426950408889634f;
template <int E0, int E1, bool LOCAL>
__device__ __forceinline__ void na_bias(f32x16& st, const float* tp, int kb) {
    if (LOCAL) { float bv[16];
#pragma unroll
        for (int e = E0; e < E1; ++e) bv[e] = tp[e];
#pragma unroll
        for (int e = E0; e < E1; ++e) st[e] = (unsigned)(kb + e) < 16u ? st[e] + bv[e] : -__builtin_inff(); }
}
template <int E0, int E1, bool LOCAL, bool FIXED>
__device__ __forceinline__ void na_tile(f32x16& st, const float* tp, int kb, float& mrun, float& lrun, f32x16& o0, f32x16& o1, bf16x8& pb0, bf16x8& pb1) {
    na_bias<E0, E1, LOCAL>(st, tp, kb);
    if (!FIXED) {
        float mt = st[E0];
#pragma unroll
        for (int e = E0 + 1; e < E1; ++e) mt = fmaxf(mt, st[e]);
        if (__any(mt > mrun + 8.f)) { const float mnew = fmaxf(mrun, fmaxf(mt, __shfl_xor(mt, 32))), sc = __builtin_amdgcn_exp2f(mrun - mnew); mrun = mnew; lrun *= sc;
#pragma unroll
            for (int e = 0; e < 16; ++e) { o0[e] *= sc; o1[e] *= sc; } } }
    float ps = 0.f; float pv[16];
#pragma unroll
    for (int e = 0; e < 16; ++e) { if (e >= E0 && e < E1) { pv[e] = __builtin_amdgcn_exp2f(st[e] - mrun); ps += pv[e]; } else pv[e] = 0.f; }
    lrun += ps;
    u32x4 w0, w1;
    w0.x = pk2(pv[0], pv[1]); w0.y = pk2(pv[2], pv[3]); w0.z = pk2(pv[4], pv[5]); w0.w = pk2(pv[6], pv[7]); w1.x = pk2(pv[8], pv[9]); w1.y = pk2(pv[10], pv[11]); w1.z = pk2(pv[12], pv[13]); w1.w = pk2(pv[14], pv[15]);
    pb0 = __builtin_bit_cast(bf16x8, w0); pb1 = __builtin_bit_cast(bf16x8, w1);
}
#define NA_TILEIDX(stp) ((size_t)(b * 32 + h) * 136 + ((stp) < 16 ? 2 * (r0 + ((stp) >> 1)) + ((stp) & 1) : 128 + ((stp) - 16)))
template <bool FIXED>
__device__ __forceinline__ void na_steps(const bf16* KF, const bf16* VF, const bf16x8* qfl, const float* tab, int b, int h, int r, int r0, int lane, int l32, int hh,
                                         f32x16 (&oacc)[2][2], float (&mrun)[2], float (&lrun)[2]) {
    bf16x8 kf[4]; bf16x8 vf[2][2];
    for (int sp = 0; sp < 12; ++sp) {
        const bool local = sp < 8;
#pragma unroll
        for (int half = 0; half < 2; ++half) {
            const int step = 2 * sp + half;
            __builtin_amdgcn_sched_barrier(0);
            { const size_t tile_ = NA_TILEIDX(step);
#pragma unroll
              for (int s = 0; s < 4; ++s) kf[s] = *(const bf16x8*)(KF + (tile_ * 4 + s) * 512 + lane * 8);
#pragma unroll
              for (int dt = 0; dt < 2; ++dt)
#pragma unroll
                  for (int s2 = 0; s2 < 2; ++s2) vf[dt][s2] = *(const bf16x8*)(VF + ((tile_ * 2 + dt) * 2 + s2) * 512 + lane * 8); }
            f32x16 st[2];
            __builtin_amdgcn_s_setprio(1);
#pragma unroll
            for (int qt = 0; qt < 2; ++qt) {
#pragma unroll
                for (int e = 0; e < 16; ++e) st[qt][e] = 0.f;
#pragma unroll
                for (int s = 0; s < 4; ++s) st[qt] = MFMA32(kf[s], qfl[(qt * 4 + s) * 64 + lane], st[qt]); }
            __builtin_amdgcn_s_setprio(0);
            bf16x8 pb[2][2];
            if (local) { const int dr31 = (r0 + sp - r + 7) * 31 + 32 * half;
#pragma unroll
                for (int qt = 0; qt < 2; ++qt) { const int qc = 32 * qt + l32; const float* tp = tab + dr31 + (15 - qc + 16 * hh); const int kb = 32 * half + 16 * hh - min(max(qc - 8, 0), 48);
                    if (qt == half) na_tile<0, 16, true, FIXED>(st[qt], tp, kb, mrun[qt], lrun[qt], oacc[0][qt], oacc[1][qt], pb[qt][0], pb[qt][1]);
                    else if (qt == 0) na_tile<0, 8, true, FIXED>(st[qt], tp, kb, mrun[qt], lrun[qt], oacc[0][qt], oacc[1][qt], pb[qt][0], pb[qt][1]);
                    else na_tile<8, 16, true, FIXED>(st[qt], tp, kb, mrun[qt], lrun[qt], oacc[0][qt], oacc[1][qt], pb[qt][0], pb[qt][1]); }
            } else {
#pragma unroll
                for (int qt = 0; qt < 2; ++qt) na_tile<0, 16, false, FIXED>(st[qt], nullptr, 0, mrun[qt], lrun[qt], oacc[0][qt], oacc[1][qt], pb[qt][0], pb[qt][1]); }
            __builtin_amdgcn_s_setprio(1);
#pragma unroll
            for (int dt = 0; dt < 2; ++dt)
#pragma unroll
                for (int s2 = 0; s2 < 2; ++s2) { const bf16x8 va = vf[dt][s2];
#pragma unroll
                    for (int qt = 0; qt < 2; ++qt) oacc[dt][qt] = MFMA32(va, pb[qt][s2], oacc[dt][qt]); }
            __builtin_amdgcn_s_setprio(0);
        }
    }
}
__device__ __forceinline__ void na_phase(ArgP a, const Ctx& c) {
    const bf16* QF = (const bf16*)(a->ws + WS_BIG); const bf16* KF = QF + pg8::NA_KF; const bf16* VF = QF + pg8::NA_VF; bf16* MIX = (bf16*)(a->ws + WS_MIX); const float* rpb = a->in[I_RPB];
    bf16x8* qfl = (bf16x8*)(c.lds + 20480 + c.wave * 8192);
    float* tab = (float*)(c.lds + c.wave * 2560) + 64;
    const int l32 = c.lane & 31, hh = c.lane >> 5;
    const int vb = (c.G % 8 == 0) ? (c.bx % 8) * (c.G / 8) + c.bx / 8 : c.bx;
    int hprev = -1;
    for (int u = vb * NWAVES + c.wave; u < NB * 32 * 64; u += c.NGW) {
        const int r = u & 63, h = (u >> 6) & 31, b = u >> 11, r0 = min(max(r - 4, 0), 56);
        if (h != hprev) { for (int i = c.lane; i < 465; i += 64) tab[i] = rpb[h * 465 + i] * LOG2E; hprev = h; }
#pragma unroll
        for (int qt = 0; qt < 2; ++qt)
#pragma unroll
            for (int s = 0; s < 4; ++s) qfl[(qt * 4 + s) * 64 + c.lane] = *(const bf16x8*)(QF + ((((size_t)(b * 32 + h) * 64 + r) * 2 + qt) * 4 + s) * 512 + c.lane * 8);
        f32x16 oacc[2][2]; float mrun[2], lrun[2] = {0.f, 0.f};
#pragma unroll
        for (int i = 0; i < 2; ++i)
#pragma unroll
            for (int j = 0; j < 2; ++j)
#pragma unroll
                for (int e = 0; e < 16; ++e) oacc[i][j][e] = 0.f;
        { float m0 = -__builtin_inff(), m1 = m0;
#pragma unroll
          for (int half = 0; half < 2; ++half) { const size_t tile_ = NA_TILEIDX(half); bf16x8 kf[4];
#pragma unroll
              for (int s = 0; s < 4; ++s) kf[s] = *(const bf16x8*)(KF + (tile_ * 4 + s) * 512 + c.lane * 8);
              const int dr31 = (r0 - r + 7) * 31 + 32 * half;
#pragma unroll
              for (int qt = 0; qt < 2; ++qt) { f32x16 st;
#pragma unroll
                  for (int e = 0; e < 16; ++e) st[e] = 0.f;
#pragma unroll
                  for (int s = 0; s < 4; ++s) st = MFMA32(kf[s], qfl[(qt * 4 + s) * 64 + c.lane], st);
                  const int qc = 32 * qt + l32; const float* tp = tab + dr31 + (15 - qc + 16 * hh); const int kb = 32 * half + 16 * hh - min(max(qc - 8, 0), 48);
                  na_bias<0, 16, true>(st, tp, kb);
                  float mt = st[0];
#pragma unroll
                  for (int e = 1; e < 16; ++e) mt = fmaxf(mt, st[e]);
                  if (qt == 0) m0 = fmaxf(m0, mt); else m1 = fmaxf(m1, mt); } }
          mrun[0] = fmaxf(m0, __shfl_xor(m0, 32)); mrun[1] = fmaxf(m1, __shfl_xor(m1, 32)); }
        na_steps<true>(KF, VF, qfl, tab, b, h, r, r0, c.lane, l32, hh, oacc, mrun, lrun);
        float lt[2] = {lrun[0] + __shfl_xor(lrun[0], 32), lrun[1] + __shfl_xor(lrun[1], 32)};
        if (__any(!(lt[0] > 1e-30f && lt[0] < 1e30f) || !(lt[1] > 1e-30f && lt[1] < 1e30f))) {
#pragma unroll
            for (int i = 0; i < 2; ++i)
#pragma unroll
                for (int j = 0; j < 2; ++j)
#pragma unroll
                    for (int e = 0; e < 16; ++e) oacc[i][j][e] = 0.f;
            mrun[0] = mrun[1] = -1e30f; lrun[0] = lrun[1] = 0.f;
            na_steps<false>(KF, VF, qfl, tab, b, h, r, r0, c.lane, l32, hh, oacc, mrun, lrun);
            lt[0] = lrun[0] + __shfl_xor(lrun[0], 32); lt[1] = lrun[1] + __shfl_xor(lrun[1], 32); }
#pragma unroll
        for (int qt = 0; qt < 2; ++qt) { const float inv = 1.f / lt[qt]; bf16* op = MIX + (size_t)(b * T + r * 64 + 32 * qt + l32) * D + h * 64 + 4 * hh;
#pragma unroll
            for (int dt = 0; dt < 2; ++dt)
#pragma unroll
                for (int g = 0; g < 4; ++g) { u32x2 w; w.x = pk2(oacc[dt][qt][4 * g] * inv, oacc[dt][qt][4 * g + 1] * inv); w.y = pk2(oacc[dt][qt][4 * g + 2] * inv, oacc[dt][qt][4 * g + 3] * inv);
                    *(u32x2*)(op + 32 * dt + 8 * g) = w; } }
    }
}
#undef NA_TILEIDX

__device__ __forceinline__ void final_norm_phase(ArgP a, const Ctx& c) {
    const float* XR = (const float*)(a->ws + WS_XR); const float* g = a->in[I_NOUT];
    f32x4 gv[8];
#pragma unroll
    for (int j = 0; j < 8; ++j) gv[j] = *(const f32x4*)(g + 4 * c.lane + 256 * j);
    f32x4 v0[8], v1[8];
#pragma unroll
    for (int j = 0; j < 8; ++j) { v0[j] = *(const f32x4*)(XR + (size_t)c.gw * D + 4 * c.lane + 256 * j); v1[j] = *(const f32x4*)(XR + (size_t)(c.gw + c.NGW) * D + 4 * c.lane + 256 * j); }
    for (int row = c.gw; row < ML; row += 2 * c.NGW) {
        const int rn = row + 2 * c.NGW; f32x4 n0[8], n1[8]; float s0 = 0.f, s1 = 0.f;
        if (rn < ML) {
#pragma unroll
            for (int j = 0; j < 8; ++j) { n0[j] = *(const f32x4*)(XR + (size_t)rn * D + 4 * c.lane + 256 * j); n1[j] = *(const f32x4*)(XR + (size_t)(rn + c.NGW) * D + 4 * c.lane + 256 * j); } }
        else {
#pragma unroll
            for (int j = 0; j < 8; ++j) { n0[j] = v0[j]; n1[j] = v1[j]; } }
#pragma unroll
        for (int j = 0; j < 8; ++j) { s0 += (v0[j].x * v0[j].x + v0[j].y * v0[j].y) + (v0[j].z * v0[j].z + v0[j].w * v0[j].w); s1 += (v1[j].x * v1[j].x + v1[j].y * v1[j].y) + (v1[j].z * v1[j].z + v1[j].w * v1[j].w); }
        const float r0 = 1.f / sqrtf(wave_sum(s0) * (1.f / D) + RMS_EPS), r1 = 1.f / sqrtf(wave_sum(s1) * (1.f / D) + RMS_EPS);
#pragma unroll
        for (int j = 0; j < 8; ++j) { *(f32x4*)(a->out + (size_t)row * D + 4 * c.lane + 256 * j) = v0[j] * r0 * gv[j]; *(f32x4*)(a->out + (size_t)(row + c.NGW) * D + 4 * c.lane + 256 * j) = v1[j] * r1 * gv[j]; }
#pragma unroll
        for (int j = 0; j < 8; ++j) { v0[j] = n0[j]; v1[j] = n1[j]; } }
}

enum Phase { PH_PROLOGUE = 0, PH_L0_N1, PH_L0_GU1, PH_L0_D1, PH_L0_NM, PH_L0_WIN, PH_L0_FN1, PH_L0_FN2, PH_L0_GA, PH_L0_GB, PH_L0_GC, PH_L0_WOUT, PH_L0_N2, PH_L0_GU2, PH_L0_D2,
             PH_L1_N1, PH_L1_GU1, PH_L1_D1, PH_L1_NM, PH_L1_QKV, PH_L1_NA, PH_L1_WOUT, PH_L1_N2, PH_L1_GU2, PH_L1_D2, PH_FINAL, NPHASES };

__global__ void __launch_bounds__(NTHR, 2) mega(Args args) {
    extern __shared__ __attribute__((aligned(16))) unsigned char lds[];
    Ctx c; c.lds = lds; c.tid = threadIdx.x; c.lane = c.tid & 63; c.wave = __builtin_amdgcn_readfirstlane(c.tid >> 6); c.bx = blockIdx.x; c.G = gridDim.x; c.gw = c.bx * NWAVES + c.wave; c.NGW = c.G * NWAVES;
    LAS unsigned char* ldsl = (LAS unsigned char*)lds;
    volatile LAS unsigned* MISC = (volatile LAS unsigned*)(ldsl + MISC_OFF);
    for (int u = c.tid; u < (LDS_BYTES - RING_BYTES) / 4; u += NTHR) ((LAS unsigned*)(ldsl + RING_BYTES))[u] = 0u;
    __syncthreads();
#define KA() ({ ArgP p_ = (ArgP)__builtin_amdgcn_kernarg_segment_ptr(); asm volatile("" : "+s"(p_)); p_; })
    unsigned char* ws = KA()->ws;
    unsigned* ctl = (unsigned*)(ws + WS_CTL);
    XcdBarrier bar; bar.bar = ctl + CW_BAR + KA()->li * XCD_BAR_WORDS; bar.x = 0; bar.st = nullptr;
    const int lo = KA()->ph_lo, hi = KA()->ph_hi;
    if (hi - lo > 1) bar = xcd_barrier_post(ctl + CW_BAR + KA()->li * XCD_BAR_WORDS, MISC + 8);
#ifndef ONLY_PH
#define ONLY_PH -1
#endif
#define IN(k) ((ONLY_PH < 0 || ONLY_PH == (k)) && lo <= (k) && (k) < hi)
    float* MODS = (float*)(ws + WS_MODS); float* XR = (float*)(ws + WS_XR); bf16* U = (bf16*)(ws + WS_U); bf16* MIX = (bf16*)(ws + WS_MIX); bf16* BIG = (bf16*)(ws + WS_BIG);

#define PH_BEGIN(k) { if (IN(k)) {
#define PH_END(k) } if (IN(k) && IN((k) + 1)) xcd_barrier(bar); }
    const int rep = KA()->rep;
    float* XRC = XR + (size_t)ML * D; float* SLAB = (float*)(ws + WS_SLAB);
    PH_BEGIN(PH_PROLOGUE) if (rep == 0) ada_units(KA(), c); tables(KA(), c); convert_layer(KA(), c, 0); PH_END(PH_PROLOGUE)

#define FFN_HALF(PN, PGU, PD, LAYER, JSUB, NORMIDX, WGU, WD, LATSRC, CTXSRC, WITHCTX) \
    PH_BEGIN(PN) norm_mod_phase(c, LATSRC, CTXSRC, KA()->in[(LAYER ? I_L1 : I_L0) + NORMIDX], MODS + (size_t)LAYER * 5 * NMODW, JSUB, U, WITHCTX, PN == PH_L0_N1 ? XRC : nullptr, (PN == PH_L0_N1 || !(WITHCTX) || rep) ? nullptr : SLAB); \
                  if (PN == PH_L1_N1) convert_layer(KA(), c, 1); PH_END(PN) \
    PH_BEGIN(PGU) pg8::PlainSched S; S.init(U, D, (WITHCTX) ? MT / 256 : ML / 256, ws + WGU, D, 2 * FF / 256, D, c.G, c.bx); pg8::EpiSwiGLU E{BIG}; \
                   pg8::gemm_phase<pg8::EpiSwiGLU, pg8::PlainSched, true>(ldsl, pg8::Gemm{64, 64, D, 0, 32768, 32768}, S, E); PH_END(PGU) \
    PH_BEGIN(PD) ResidSched S; S.init(BIG, FF, ws + WD, FF, FF, WITHCTX, c.G, c.bx, 32768); \
                  pg8::EpiResid E{rep ? XR : LATSRC, rep ? XRC : CTXSRC, XR, MODS + (size_t)LAYER * 5 * NMODW + (3 * JSUB + 2) * D, SLAB, rep ? 0.f : 0.5f}; \
                  pg8::gemm_phase<pg8::EpiResid, ResidSched, true>(ldsl, pg8::Gemm{64, 64, FF, 0, 32768, 32768}, S, E); PH_END(PD)

    FFN_HALF(PH_L0_N1, PH_L0_GU1, PH_L0_D1, 0, 0, 2, W_GU1, W_D1, KA()->in[I_X], KA()->in[I_CTX], true)
    PH_BEGIN(PH_L0_NM) norm_mod_phase(c, XR, XRC, KA()->in[I_L0 + 3], MODS, 1, U, true, nullptr, rep ? nullptr : SLAB); PH_END(PH_L0_NM)
    PH_BEGIN(PH_L0_WIN) StoreSched S; S.p.init(U, D, MT / 256, ws + W_MIXA, D, ZW / 256, D, c.G, c.bx); S.ldc = ZW; S.nscale = 0; S.sc0 = 1.f; pg8::EpiStore E{BIG};
        pg8::gemm_phase<pg8::EpiStore, StoreSched, true>(ldsl, pg8::Gemm{64, 64, D, 0, 32768, 32768}, S, E); PH_END(PH_L0_WIN)
    PH_BEGIN(PH_L0_FN1) Fn1Sched S{c.G, c.bx, (const char*)(ws + WS_DFTC), (const char*)BIG}; pg8::EpiStore E{(bf16*)(ws + WS_F1T)};
        pg8::gemm_phase<pg8::EpiStore, Fn1Sched, true>(ldsl, pg8::Gemm{256, ZW, 256, 1, 128, 128}, S, E);
        { Fn1cSched Sc{c.G, (c.bx + 64) % c.G, (const char*)(ws + WS_DFTC), (const char*)BIG}; pg8::gemm_phase<pg8::EpiStore, Fn1cSched, true>(ldsl, pg8::Gemm{256, ZW, 256, 0, 128, 128}, Sc, E); }
        gla_a_phase(KA(), c); PH_END(PH_L0_FN1)
    PH_BEGIN(PH_L0_FN2) { FabSched S{c.G, c.bx, (const char*)(ws + WS_WA), (const char*)(ws + WS_F1T)}; pg8::EpiFnA E{(bf16*)(ws + WS_YP), (const float*)(ws + WS_TW)};
          pg8::gemm_phase<pg8::EpiFnA, FabSched, true>(ldsl, pg8::Gemm{128, 128, 128, 0, 128, 128}, S, E); }
        gla_b_phase(KA(), c); PH_END(PH_L0_FN2)
    PH_BEGIN(PH_L0_GC) { FabSched S{c.G, c.bx, (const char*)(ws + WS_WB), (const char*)(ws + WS_YP)}; pg8::EpiFnB E{MIX};
          pg8::gemm_phase<pg8::EpiFnB, FabSched, true>(ldsl, pg8::Gemm{128, 128, 128, 0, 128, 128}, S, E); }
        { Fn2cSched S{c.G, (c.bx + 192) % c.G, (const char*)(ws + WS_DFT256), (const char*)(ws + WS_F1TC)}; pg8::EpiStore E{MIX};
          pg8::gemm_phase<pg8::EpiStore, Fn2cSched, true>(ldsl, pg8::Gemm{512, 512, 512, 0, 128, 128}, S, E); }
        gla_c_phase(KA(), c); PH_END(PH_L0_GC)
    PH_BEGIN(PH_L0_WOUT) ResidSched S; S.init(MIX, D, ws + W_OUT, D, D, true, c.G, c.bx); pg8::EpiResid E{XR, XRC, XR, MODS + 5 * D, SLAB, rep ? 0.f : 1.f};
        pg8::gemm_phase<pg8::EpiResid, ResidSched, true>(ldsl, pg8::Gemm{D, 64, D, 0, 128, 32768}, S, E); PH_END(PH_L0_WOUT)
    FFN_HALF(PH_L0_N2, PH_L0_GU2, PH_L0_D2, 0, 2, 4, W_GU2, W_D2, XR, XRC, true)

    FFN_HALF(PH_L1_N1, PH_L1_GU1, PH_L1_D1, 1, 0, 2, W_GU1, W_D1, XR, XRC, true)
    PH_BEGIN(PH_L1_NM) norm_mod_phase(c, XR, XRC, KA()->in[I_L1 + 3], MODS + (size_t)5 * NMODW, 1, U, true, nullptr, rep ? nullptr : SLAB); PH_END(PH_L1_NM)
    PH_BEGIN(PH_L1_QKV) QkvSched S{c.G, c.bx, (const char*)U, (const char*)(ws + W_MIXA)}; pg8::EpiQkvFrag E{BIG};
        pg8::gemm_phase<pg8::EpiQkvFrag, QkvSched, true>(ldsl, pg8::Gemm{64, 64, D, 0, 32768, 32768}, S, E); PH_END(PH_L1_QKV)
    PH_BEGIN(PH_L1_NA) na_phase(KA(), c); PH_END(PH_L1_NA)
    PH_BEGIN(PH_L1_WOUT) ResidSched S; S.init(MIX, D, ws + W_OUT, D, D, false, c.G, c.bx); pg8::EpiResid E{XR, XRC, XR, MODS + (size_t)5 * NMODW + 5 * D, SLAB, rep ? 0.f : 1.f};
        pg8::gemm_phase<pg8::EpiResid, ResidSched, true>(ldsl, pg8::Gemm{D, 64, D, 0, 128, 32768}, S, E); PH_END(PH_L1_WOUT)
    FFN_HALF(PH_L1_N2, PH_L1_GU2, PH_L1_D2, 1, 2, 4, W_GU2, W_D2, XR, XRC, false)
    PH_BEGIN(PH_FINAL) final_norm_phase(KA(), c); PH_END(PH_FINAL)
#undef IN
#undef FFN_HALF
}

extern "C" void kernel_launch(void* const* d_in, const int* in_sizes, int n_in, void* d_out, int out_size, void* d_ws, size_t ws_size, hipStream_t stream) {
    static int grid = 0;
    if (grid == 0) {
        if (n_in != 33 || in_sizes[0] != ML * D || out_size != ML * D || ws_size < WS_END) { fprintf(stderr, "kernel_launch: unexpected problem (n_in %d, in0 %d, out %d, ws %zu < %zu)\n", n_in, n_in > 0 ? in_sizes[0] : -1, out_size, ws_size, (size_t)WS_END); grid = -1; return; }
        int dev = 0, cus = 0, per_cu = 0;
        if (hipGetDevice(&dev) != hipSuccess || hipDeviceGetAttribute(&cus, hipDeviceAttributeMultiprocessorCount, dev) != hipSuccess) { grid = -1; return; }
        if (hipFuncSetAttribute((const void*)mega, hipFuncAttributeMaxDynamicSharedMemorySize, LDS_BYTES) != hipSuccess) { fprintf(stderr, "kernel_launch: hipFuncSetAttribute failed\n"); grid = -1; return; }
        if (hipOccupancyMaxActiveBlocksPerMultiprocessor(&per_cu, (const void*)mega, NTHR, LDS_BYTES) != hipSuccess || per_cu < 1) fprintf(stderr, "kernel_launch: occupancy query says %d\n", per_cu);
        (void)hipGetLastError();
        grid = cus;
    }
    if (grid < 0) return;
    (void)hipMemsetAsync((char*)d_ws + WS_CTL, 0, CTL_ZERO_BYTES, stream);
    Args a{};
    for (int i = 0; i < 33; ++i) a.in[i] = (const float*)d_in[i];
    a.out = (float*)d_out; a.ws = (unsigned char*)d_ws;
#if MK_FUSED
#ifdef PROBE_PHASES
    { const int rp[] = {PROBE_PHASES}; const int nrp = (int)(sizeof(rp) / sizeof(rp[0])); int lo = 0, li = 0;
      for (int i = 0; i <= nrp; ++i) { const int hi = i < nrp ? rp[i] + 1 : NPHASES;
          if (hi > lo) { a.ph_lo = lo; a.ph_hi = hi; a.rep = 0; a.li = li++; hipLaunchKernelGGL(mega, dim3(grid), dim3(NTHR), LDS_BYTES, stream, a); }
          if (i < nrp) { a.ph_lo = rp[i]; a.ph_hi = rp[i] + 1; a.rep = 1; a.li = li++; hipLaunchKernelGGL(mega, dim3(grid), dim3(NTHR), LDS_BYTES, stream, a); }
          lo = hi; } }
#else
    a.ph_lo = 0; a.ph_hi = NPHASES; hipLaunchKernelGGL(mega, dim3(grid), dim3(NTHR), LDS_BYTES, stream, a);
#endif
#else
    for (int ph = 0; ph < NPHASES; ++ph) { a.ph_lo = ph; a.ph_hi = ph + 1; hipLaunchKernelGGL(mega, dim3(grid), dim3(NTHR), LDS_BYTES, stream, a); }
#endif
}
```
